# Optimizing an MI355X kernel written in HIP

```python
import math
import jax, jax.numpy as jnp
from jax import lax
import numpy as np


D_MODEL = 1024
BATCH = 8
SEQ = 2048
DEPTH = 2

CHUNK = 64
Q_BLOCK = 128
N_EVEN = (DEPTH + 1) // 2
N_ODD = DEPTH // 2

MLA_HEADS = 8
MLA_Q_LORA = 384
MLA_KV_LORA = 256
MLA_NOPE = 64
MLA_ROPE = 32
MLA_V = 64
SB_HEADS = 8
SB_HEAD_DIM = 64
SB_W = SB_HEADS * SB_HEAD_DIM
AB_WIDTH = MLA_HEADS * MLA_V + SB_W
AB_IN = MLA_Q_LORA + MLA_KV_LORA + MLA_ROPE + 3 * SB_W + AB_WIDTH
DIFF_HEADS = 8
DIFF_HEAD_DIM = 64
DIFF_QK = DIFF_HEADS * 2 * DIFF_HEAD_DIM
DIFF_WIDTH = DIFF_HEADS * 2 * DIFF_HEAD_DIM
DIFF_IN = 2 * DIFF_QK + 2 * DIFF_WIDTH

REL_BUCKETS = 32
REL_MAX_DIST = 128
ROPE_THETA = 10000.0
NORM_EPS = 1e-6
SUBLN_EPS = 1e-5
NEG_INF = -1e30

kernel_name = 'hybrid_mla_stickbreak_diffattn_encoder'


def rms_norm(x, g, eps=NORM_EPS):
    xf = x.astype(jnp.float32)
    y = xf * lax.rsqrt(jnp.mean(xf * xf, axis=-1, keepdims=True) + eps)
    return (y * g.astype(jnp.float32)).astype(x.dtype)


def rope(x, pos):
    half = x.shape[-1] // 2
    inv_freq = ROPE_THETA ** (-jnp.arange(half, dtype=jnp.float32) / half)
    ang = pos.astype(jnp.float32)[..., None, None] * inv_freq
    cos, sin = jnp.cos(ang), jnp.sin(ang)
    xf = x.astype(jnp.float32)
    x1, x2 = xf[..., :half], xf[..., half:]
    return jnp.concatenate([x1 * cos - x2 * sin, x1 * sin + x2 * cos], axis=-1).astype(x.dtype)


def t5_bucket(rel):
    nb = REL_BUCKETS // 2
    max_exact = nb // 2
    ret = jnp.where(rel > 0, nb, 0)
    n = jnp.abs(rel)
    nf = jnp.maximum(n, 1).astype(jnp.float32)
    large = max_exact + (jnp.log(nf / max_exact) / math.log(REL_MAX_DIST / max_exact) * (nb - max_exact)).astype(jnp.int32)
    large = jnp.minimum(large, nb - 1)
    return ret + jnp.where(n < max_exact, n, large)


def chunk_mask(qs, ke):
    tq = qs + jnp.arange(Q_BLOCK)
    tk = jnp.arange(ke)
    return (tk // CHUNK)[None, :] <= (tq // CHUNK)[:, None]


def sweep(block_fn, seq):
    return jnp.concatenate([block_fn(i * Q_BLOCK, (i + 1) * Q_BLOCK) for i in range(seq // Q_BLOCK)], axis=1)


def mla_attention(q, k, v):
    scale = (MLA_NOPE + MLA_ROPE) ** -0.5

    def block(qs, ke):
        s = jnp.einsum('bqhd,bkhd->bhqk', q[:, qs:ke], k[:, :ke]).astype(jnp.float32) * scale
        s = jnp.where(chunk_mask(qs, ke), s, NEG_INF)
        p = jax.nn.softmax(s, axis=-1).astype(v.dtype)
        return jnp.einsum('bhqk,bkhd->bqhd', p, v[:, :ke])

    return sweep(block, q.shape[1])


def stick_breaking_attention(q, k, v):
    scale = SB_HEAD_DIM ** -0.5

    def block(qs, ke):
        z = jnp.einsum('bqhd,bkhd->bhqk', q[:, qs:ke], k[:, :ke]).astype(jnp.float32) * scale
        tq = qs + jnp.arange(Q_BLOCK)
        tk = jnp.arange(ke)
        m = tk[None, :] < tq[:, None]
        log_1m = jnp.where(m, jax.nn.log_sigmoid(-z), 0.0)
        csum = jnp.cumsum(log_1m, axis=-1)
        log_w = jax.nn.log_sigmoid(z) + csum[..., -1:] - csum
        w = jnp.where(m, jnp.exp(log_w), 0.0).astype(v.dtype)
        return jnp.einsum('bhqk,bkhd->bqhd', w, v[:, :ke])

    return sweep(block, q.shape[1])


def layer_ab(h, pos, w_in, q_norm_g, kv_norm_g, w_uq, w_ukv, w_out):
    B, S, _ = h.shape
    proj = h @ w_in
    cuts = np.cumsum([MLA_Q_LORA, MLA_KV_LORA, MLA_ROPE, SB_W, SB_W, SB_W]).tolist()
    cq, ckv, kr, q_sb, k_sb, v_sb, z = jnp.split(proj, cuts, axis=-1)
    q = (rms_norm(cq, q_norm_g) @ w_uq).reshape(B, S, MLA_HEADS, MLA_NOPE + MLA_ROPE)
    q = jnp.concatenate([q[..., :MLA_NOPE], rope(q[..., MLA_NOPE:], pos)], axis=-1)
    kv = (rms_norm(ckv, kv_norm_g) @ w_ukv).reshape(B, S, MLA_HEADS, MLA_NOPE + MLA_V)
    k_rope = jnp.broadcast_to(rope(kr[:, :, None, :], pos), (B, S, MLA_HEADS, MLA_ROPE))
    k = jnp.concatenate([kv[..., :MLA_NOPE], k_rope], axis=-1)
    o_mla = mla_attention(q, k, kv[..., MLA_NOPE:]).reshape(B, S, MLA_HEADS * MLA_V)
    shp = (B, S, SB_HEADS, SB_HEAD_DIM)
    o_sb = stick_breaking_attention(q_sb.reshape(shp), k_sb.reshape(shp), v_sb.reshape(shp)).reshape(B, S, SB_W)
    y = jnp.concatenate([o_mla, o_sb], axis=-1) * jax.nn.silu(z)
    return y @ w_out


def layer_diff(h, rel_table, w_in, lq1, lk1, lq2, lk2, subln_g, w_out, lam_init):
    B, S, _ = h.shape
    proj = h @ w_in
    q, k, v, z = jnp.split(proj, [DIFF_QK, 2 * DIFF_QK, 2 * DIFF_QK + DIFF_WIDTH], axis=-1)
    q = q.reshape(B, S, DIFF_HEADS, 2, DIFF_HEAD_DIM)
    k = k.reshape(B, S, DIFF_HEADS, 2, DIFF_HEAD_DIM)
    v = v.reshape(B, S, DIFF_HEADS, 2 * DIFF_HEAD_DIM)
    f32 = jnp.float32
    lam = (jnp.exp(jnp.sum(lq1.astype(f32) * lk1.astype(f32)))
           - jnp.exp(jnp.sum(lq2.astype(f32) * lk2.astype(f32))) + lam_init)
    scale = DIFF_HEAD_DIM ** -0.5
    table = rel_table.astype(f32)

    def block(qs, ke):
        tq = qs + jnp.arange(Q_BLOCK)
        tk = jnp.arange(ke)
        bias = table[t5_bucket(tk[None, :] - tq[:, None])].transpose(2, 0, 1)
        s = jnp.einsum('bqhcd,bkhcd->cbhqk', q[:, qs:ke], k[:, :ke]).astype(f32) * scale + bias
        s = jnp.where(chunk_mask(qs, ke), s, NEG_INF)
        p = jax.nn.softmax(s, axis=-1)
        a = (p[0] - lam * p[1]).astype(v.dtype)
        return jnp.einsum('bhqk,bkhd->bqhd', a, v[:, :ke])

    o = sweep(block, S)
    o = rms_norm(o, subln_g, SUBLN_EPS) * (1.0 - lam_init)
    y = o.reshape(B, S, DIFF_WIDTH) * jax.nn.silu(z)
    return y @ w_out


def setup_inputs(seed: int = 0) -> dict:
    key = jax.random.key(seed)
    ks = jax.random.split(key, 24)
    nrm = lambda k, shape, s: jax.random.normal(k, shape, jnp.float32) * s
    D = D_MODEL
    return {
        'x': nrm(ks[0], (BATCH, SEQ, D), 1.0),
        'c': nrm(ks[1], (BATCH, D), 1.0),
        'pos_offset': (jax.random.randint(ks[2], (BATCH,), 0, 64) * CHUNK).astype(jnp.int32),
        'rel_bias_table': nrm(ks[3], (REL_BUCKETS, DIFF_HEADS), 0.5),
        'ada_w': nrm(ks[4], (DEPTH, D, 3 * D), D ** -0.5),
        'ada_b': nrm(ks[5], (DEPTH, 3 * D), 0.01),
        'norm_g': 1.0 + nrm(ks[6], (DEPTH, D), 0.01),
        'final_g': 1.0 + nrm(ks[7], (D,), 0.01),
        'ab_w_in': nrm(ks[8], (N_EVEN, D, AB_IN), D ** -0.5),
        'ab_q_norm_g': 1.0 + nrm(ks[9], (N_EVEN, MLA_Q_LORA), 0.01),
        'ab_kv_norm_g': 1.0 + nrm(ks[10], (N_EVEN, MLA_KV_LORA), 0.01),
        'ab_w_uq': nrm(ks[11], (N_EVEN, MLA_Q_LORA, MLA_HEADS * (MLA_NOPE + MLA_ROPE)), MLA_Q_LORA ** -0.5),
        'ab_w_ukv': nrm(ks[12], (N_EVEN, MLA_KV_LORA, MLA_HEADS * (MLA_NOPE + MLA_V)), MLA_KV_LORA ** -0.5),
        'ab_w_out': nrm(ks[13], (N_EVEN, AB_WIDTH, D), AB_WIDTH ** -0.5),
        'dif_w_in': nrm(ks[14], (N_ODD, D, DIFF_IN), D ** -0.5),
        'dif_lam_q1': nrm(ks[15], (N_ODD, DIFF_HEAD_DIM), 0.1),
        'dif_lam_k1': nrm(ks[16], (N_ODD, DIFF_HEAD_DIM), 0.1),
        'dif_lam_q2': nrm(ks[17], (N_ODD, DIFF_HEAD_DIM), 0.1),
        'dif_lam_k2': nrm(ks[18], (N_ODD, DIFF_HEAD_DIM), 0.1),
        'dif_subln_g': 1.0 + nrm(ks[19], (N_ODD, 2 * DIFF_HEAD_DIM), 0.01),
        'dif_w_out': nrm(ks[20], (N_ODD, DIFF_WIDTH, D), DIFF_WIDTH ** -0.5),
    }


def reference(x, c, pos_offset, rel_bias_table, ada_w, ada_b, norm_g, final_g,
              ab_w_in, ab_q_norm_g, ab_kv_norm_g, ab_w_uq, ab_w_ukv, ab_w_out,
              dif_w_in, dif_lam_q1, dif_lam_k1, dif_lam_q2, dif_lam_k2, dif_subln_g, dif_w_out):
    B, S, _ = x.shape
    pos = pos_offset[:, None] + jnp.arange(S, dtype=jnp.int32)[None, :]
    c_act = jax.nn.silu(c)
    for i in range(DEPTH):
        mod = c_act @ ada_w[i] + ada_b[i]
        shift, scale, gate = jnp.split(mod, 3, axis=-1)
        h = rms_norm(x, norm_g[i]) * (1.0 + scale[:, None, :]) + shift[:, None, :]
        j = i // 2
        if i % 2 == 0:
            out = layer_ab(h, pos, ab_w_in[j], ab_q_norm_g[j], ab_kv_norm_g[j],
                           ab_w_uq[j], ab_w_ukv[j], ab_w_out[j])
        else:
            lam_init = 0.8 - 0.6 * math.exp(-0.3 * i)
            out = layer_diff(h, rel_bias_table, dif_w_in[j], dif_lam_q1[j], dif_lam_k1[j],
                             dif_lam_q2[j], dif_lam_k2[j], dif_subln_g[j], dif_w_out[j], lam_init)
        x = x + gate[:, None, :] * out
    return rms_norm(x, final_g)
```

```cpp
#include <hip/hip_runtime.h>
#include <cstdio>
#include <cstdint>
#include <cmath>

typedef unsigned short bf16_t;
#define GAS __attribute__((address_space(1)))
#define LAS __attribute__((address_space(3)))

constexpr int D = 1024, BATCH = 8, SEQ = 2048, M = BATCH * SEQ;
constexpr int MOD_W = 3 * D;
constexpr int AB_IN = 3232, N0P = 3328;
constexpr int DIFF_IN = 4096;
constexpr float LOG2E = 1.4426950408889634f;
constexpr float C_SB = 0.125f * LOG2E;
constexpr float C_MLA = 0.10206207261596577f * LOG2E;
constexpr float LAM_INIT = 0.35550906759096927f;
constexpr float NORM_EPS = 1e-6f, SUBLN_EPS = 1e-5f;

constexpr size_t MiB = 1u << 20;
constexpr size_t WS_CTL = 0, CTL_ZERO_BYTES = 1 * MiB;
constexpr size_t WS_MOD = 512 * 1024;
constexpr size_t WS_W0T = 1 * MiB;
constexpr size_t WS_WUQT = 8 * MiB;
constexpr size_t WS_WUKVT = 9 * MiB;
constexpr size_t WS_WO0T = 10 * MiB;
constexpr size_t WS_W1T = 12 * MiB;
constexpr size_t WS_WO1T = 20 * MiB;
constexpr size_t WS_RT = 22 * MiB;
constexpr size_t WS_HY = 24 * MiB;
constexpr size_t WS_CQ = 56 * MiB;
constexpr size_t WS_CKV = 68 * MiB;
constexpr size_t WS_QSB = 76 * MiB, WS_KSB = 92 * MiB, WS_VSB = 108 * MiB;
constexpr size_t WS_ZG0 = 124 * MiB;
constexpr size_t WS_QM = 156 * MiB, WS_KM = 180 * MiB;
constexpr size_t WS_VM = 204 * MiB;
constexpr size_t WS_RSTD = 220 * MiB;
constexpr size_t WS_Q1 = 56 * MiB, WS_K1 = 88 * MiB, WS_V1 = 120 * MiB, WS_ZG1 = 152 * MiB;
constexpr size_t WS_END = 224 * MiB;

__device__ __forceinline__ unsigned f2bf(float f) { unsigned u = __builtin_bit_cast(unsigned, f); return (u + 0x7fffu + ((u >> 16) & 1u)) >> 16; }
__device__ __forceinline__ float bf2f(unsigned h) { return __builtin_bit_cast(float, h << 16); }
__device__ __forceinline__ unsigned pk2(float lo, float hi) { return f2bf(lo) | (f2bf(hi) << 16); }
__device__ __forceinline__ float silu_f(float v) { return v / (1.0f + __expf(-v)); }
__host__ __device__ __forceinline__ int ropeidx(int p) { const int g = p >> 3, e = p & 7; return e < 4 ? 4 * g + e : 16 + 4 * g + (e - 4); }
__host__ __device__ __forceinline__ int ropeslot(int i) { return 8 * (i >> 2) + (i & 3); }
__host__ __device__ __forceinline__ int t5_bucket(int rel) {
    const int n = rel < 0 ? -rel : rel; int v;
    if (n < 8) v = n; else if (n < 12) v = 8; else if (n < 16) v = 9; else if (n < 23) v = 10; else if (n < 32) v = 11; else if (n < 46) v = 12; else if (n < 64) v = 13; else if (n < 91) v = 14; else v = 15;
    return (rel > 0 ? 16 : 0) + v;
}
__host__ __device__ __forceinline__ int w0_src(int n) {
    if (n < 640) return n;
    if (n < 672) return 640 + ropeidx(n - 640);
    if (n < 768) return -1;
    return n - 96;
}
__host__ __device__ __forceinline__ int wuq_src(int n) { const int h = n / 96, j = n % 96; return j < 64 ? n : 96 * h + 64 + ropeidx(j - 64); }

struct Ptrs {
    const float* x; const float* c; const int* pos_offset; const float* rel_table; const float* ada_w; const float* ada_b; const float* norm_g; const float* final_g;
    const float* ab_w_in; const float* ab_q_norm_g; const float* ab_kv_norm_g; const float* ab_w_uq; const float* ab_w_ukv; const float* ab_w_out;
    const float* dif_w_in; const float* lq1; const float* lk1; const float* lq2; const float* lk2; const float* subln_g; const float* dif_w_out;
    float* out; unsigned char* ws;
};
namespace nv {

__global__ void k_mod(Ptrs p) {
    const int idx = blockIdx.x * blockDim.x + threadIdx.x;
    if (idx >= 2 * BATCH * MOD_W) return;
    const int n = idx % MOD_W, b = (idx / MOD_W) % BATCH, i = idx / (MOD_W * BATCH);
    const float* w = p.ada_w + (size_t)i * D * MOD_W + n; const float* cb = p.c + (size_t)b * D;
    float acc = 0.f;
    for (int k = 0; k < D; ++k) acc += silu_f(cb[k]) * w[(size_t)k * MOD_W];
    ((float*)(p.ws + WS_MOD))[idx] = acc + p.ada_b[i * MOD_W + n];
}
__global__ void k_wt(Ptrs p) {
    const size_t gid = (size_t)blockIdx.x * blockDim.x + threadIdx.x;
    const size_t n0 = (size_t)N0P * D, n1 = (size_t)768 * 384, n2 = (size_t)1024 * 256, n3 = (size_t)D * D, n4 = (size_t)DIFF_IN * D, n5 = (size_t)D * D;
    size_t r = gid;
    if (r < n0) { const int n = (int)(r / D), k = (int)(r % D); const int s = w0_src(n); ((bf16_t*)(p.ws + WS_W0T))[r] = (bf16_t)(s < 0 ? 0u : f2bf(p.ab_w_in[(size_t)k * AB_IN + s])); return; } r -= n0;
    if (r < n1) { const int n = (int)(r / 384), k = (int)(r % 384); ((bf16_t*)(p.ws + WS_WUQT))[r] = (bf16_t)f2bf(p.ab_q_norm_g[k] * p.ab_w_uq[(size_t)k * 768 + wuq_src(n)]); return; } r -= n1;
    if (r < n2) { const int n = (int)(r / 256), k = (int)(r % 256); ((bf16_t*)(p.ws + WS_WUKVT))[r] = (bf16_t)f2bf(p.ab_kv_norm_g[k] * p.ab_w_ukv[(size_t)k * 1024 + n]); return; } r -= n2;
    if (r < n3) { const int n = (int)(r / D), k = (int)(r % D); ((bf16_t*)(p.ws + WS_WO0T))[r] = (bf16_t)f2bf(p.ab_w_out[(size_t)k * D + n]); return; } r -= n3;
    if (r < n4) { const int n = (int)(r / D), k = (int)(r % D); ((bf16_t*)(p.ws + WS_W1T))[r] = (bf16_t)f2bf(p.dif_w_in[(size_t)k * DIFF_IN + n]); return; } r -= n4;
    if (r < n5) { const int n = (int)(r / D), k = (int)(r % D); ((bf16_t*)(p.ws + WS_WO1T))[r] = (bf16_t)f2bf(p.dif_w_out[(size_t)k * D + n]); return; }
}
__global__ void k_rt(Ptrs p) {
    const int idx = blockIdx.x * blockDim.x + threadIdx.x; if (idx >= M * 16) return;
    const int row = idx >> 4, i = idx & 15, b = row / SEQ, t = row % SEQ;
    const float pos = (float)(p.pos_offset[b] + t), inv = powf(10000.0f, -(float)i / 16.0f), ang = pos * inv;
    float s, c; sincosf(ang, &s, &c);
    ((float2*)(p.ws + WS_RT))[idx] = make_float2(c, s);
}
__global__ void k_normmod(Ptrs p, const float* xin, int layer) {
    __shared__ float red[256];
    const int row = blockIdx.x, b = row / SEQ, tid = threadIdx.x;
    const float* xr = xin + (size_t)row * D; float v[4], s = 0.f;
    for (int j = 0; j < 4; ++j) { v[j] = xr[tid + 256 * j]; s += v[j] * v[j]; }
    red[tid] = s; __syncthreads();
    for (int o = 128; o > 0; o >>= 1) { if (tid < o) red[tid] += red[tid + o]; __syncthreads(); }
    const float rstd = 1.0f / sqrtf(red[0] / D + NORM_EPS);
    const float* mod = (const float*)(p.ws + WS_MOD) + (size_t)(layer * BATCH + b) * MOD_W;
    bf16_t* h = (bf16_t*)(p.ws + WS_HY) + (size_t)row * D;
    for (int j = 0; j < 4; ++j) { const int n = tid + 256 * j; h[n] = (bf16_t)f2bf(v[j] * rstd * p.norm_g[layer * D + n] * (1.0f + mod[D + n]) + mod[n]); }
}
template <class Epi> __global__ void __launch_bounds__(256) k_gemm(const bf16_t* A, int lda, const bf16_t* Bt, int Mrows, int N, int K, Epi E) {
    __shared__ __attribute__((aligned(16))) float As[16][68], Bs[16][68];
    const int tid = threadIdx.x, tx = tid & 15, ty = tid >> 4, m0 = blockIdx.y * 64, n0 = blockIdx.x * 64;
    float acc[4][4]; for (int i = 0; i < 4; ++i) for (int j = 0; j < 4; ++j) acc[i][j] = 0.f;
    const int lr = tid >> 2, lk = (tid & 3) * 4;
    for (int k0 = 0; k0 < K; k0 += 16) {
        for (int e = 0; e < 4; ++e) { As[lk + e][lr] = bf2f(A[(size_t)(m0 + lr) * lda + k0 + lk + e]); Bs[lk + e][lr] = bf2f(Bt[(size_t)(n0 + lr) * K + k0 + lk + e]); }
        __syncthreads();
#pragma unroll
        for (int k = 0; k < 16; ++k) { float a[4], b[4];
#pragma unroll
            for (int i = 0; i < 4; ++i) { a[i] = As[k][ty * 4 + i]; b[i] = Bs[k][tx * 4 + i]; }
#pragma unroll
            for (int i = 0; i < 4; ++i)
#pragma unroll
                for (int j = 0; j < 4; ++j) acc[i][j] += a[i] * b[j]; }
        __syncthreads();
    }
#pragma unroll
    for (int i = 0; i < 4; ++i)
#pragma unroll
        for (int j = 0; j < 4; ++j) E(m0 + ty * 4 + i, n0 + tx * 4 + j, acc[i][j]);
}
struct EG1 { unsigned char* ws;
    __device__ void operator()(int row, int col, float v) const {
        if (col < 384) ((bf16_t*)(ws + WS_CQ))[(size_t)row * 384 + col] = (bf16_t)f2bf(v);
        else if (col < 640) ((bf16_t*)(ws + WS_CKV))[(size_t)row * 256 + col - 384] = (bf16_t)f2bf(v);
        else if (col < 768) return;
        else if (col < 1280) ((bf16_t*)(ws + WS_QSB))[(size_t)row * 512 + col - 768] = (bf16_t)f2bf(v * C_SB);
        else if (col < 1792) ((bf16_t*)(ws + WS_KSB))[(size_t)row * 512 + col - 1280] = (bf16_t)f2bf(v);
        else if (col < 2304) ((bf16_t*)(ws + WS_VSB))[(size_t)row * 512 + col - 1792] = (bf16_t)f2bf(v);
        else ((bf16_t*)(ws + WS_ZG0))[(size_t)row * 1024 + col - 2304] = (bf16_t)f2bf(silu_f(v)); } };
struct EG2a { unsigned char* ws;
    __device__ void operator()(int row, int col, float v) const { if (col % 96 >= 64) return;
        ((bf16_t*)(ws + WS_QM))[(size_t)row * 768 + col] = (bf16_t)f2bf(v * ((const float*)(ws + WS_RSTD))[row] * C_MLA); } };
struct EG2b { unsigned char* ws;
    __device__ void operator()(int row, int col, float v) const { const int h = col >> 7, j = col & 127; const float o = v * ((const float*)(ws + WS_RSTD))[M + row];
        if (j < 64) ((bf16_t*)(ws + WS_KM))[(size_t)row * 768 + 96 * h + j] = (bf16_t)f2bf(o); else ((bf16_t*)(ws + WS_VM))[(size_t)row * 512 + 64 * h + j - 64] = (bf16_t)f2bf(o); } };
struct EG3 { unsigned char* ws; const float* xin; float* xout; int layer;
    __device__ void operator()(int row, int col, float v) const { const int b = row / SEQ; const float g = ((const float*)(ws + WS_MOD))[(size_t)(layer * BATCH + b) * MOD_W + 2 * D + col];
        xout[(size_t)row * D + col] = xin[(size_t)row * D + col] + g * v; } };
struct EG4 { unsigned char* ws;
    __device__ void operator()(int row, int col, float v) const {
        if (col < 1024) ((bf16_t*)(ws + WS_Q1))[(size_t)row * 1024 + col] = (bf16_t)f2bf(v * C_SB);
        else if (col < 2048) ((bf16_t*)(ws + WS_K1))[(size_t)row * 1024 + col - 1024] = (bf16_t)f2bf(v);
        else if (col < 3072) ((bf16_t*)(ws + WS_V1))[(size_t)row * 1024 + col - 2048] = (bf16_t)f2bf(v);
        else ((bf16_t*)(ws + WS_ZG1))[(size_t)row * 1024 + col - 3072] = (bf16_t)f2bf(silu_f(v)); } };
__global__ void k_kr(Ptrs p) {
    const int idx = blockIdx.x * blockDim.x + threadIdx.x; if (idx >= M * 16) return;
    const int row = idx >> 4, i = idx & 15, s = ropeslot(i);
    const bf16_t* h = (const bf16_t*)(p.ws + WS_HY) + (size_t)row * D; const bf16_t* w1 = (const bf16_t*)(p.ws + WS_W0T) + (size_t)(640 + s) * D; const bf16_t* w2 = w1 + 4 * D;
    float a1 = 0.f, a2 = 0.f; for (int k = 0; k < D; ++k) { const float hv = bf2f(h[k]); a1 += hv * bf2f(w1[k]); a2 += hv * bf2f(w2[k]); }
    const float2 cs = ((const float2*)(p.ws + WS_RT))[idx]; const float o1 = a1 * cs.x - a2 * cs.y, o2 = a1 * cs.y + a2 * cs.x;
    bf16_t* km = (bf16_t*)(p.ws + WS_KM) + (size_t)row * 768 + 64 + s;
    for (int hh = 0; hh < 8; ++hh) { km[96 * hh] = (bf16_t)f2bf(o1); km[96 * hh + 4] = (bf16_t)f2bf(o2); }
}
__global__ void k_rstd(const bf16_t* src, int W, float* dst) {
    const int row = blockIdx.x * blockDim.x + threadIdx.x; if (row >= M) return;
    float s = 0.f; for (int k = 0; k < W; ++k) { const float v = bf2f(src[(size_t)row * W + k]); s += v * v; }
    dst[row] = 1.0f / sqrtf(s / W + NORM_EPS);
}
__global__ void k_qrope(Ptrs p) {
    const int idx = blockIdx.x * blockDim.x + threadIdx.x; if (idx >= M * 128) return;
    const int row = idx >> 7, hh = (idx >> 4) & 7, i = idx & 15, s = ropeslot(i), col = 96 * hh + 64 + s;
    const bf16_t* a = (const bf16_t*)(p.ws + WS_CQ) + (size_t)row * 384; const bf16_t* w1 = (const bf16_t*)(p.ws + WS_WUQT) + (size_t)col * 384; const bf16_t* w2 = w1 + 4 * 384;
    float a1 = 0.f, a2 = 0.f; for (int k = 0; k < 384; ++k) { const float av = bf2f(a[k]); a1 += av * bf2f(w1[k]); a2 += av * bf2f(w2[k]); }
    const float sc = ((const float*)(p.ws + WS_RSTD))[row] * C_MLA; a1 *= sc; a2 *= sc;
    const float2 cs = ((const float2*)(p.ws + WS_RT))[row * 16 + i];
    bf16_t* q = (bf16_t*)(p.ws + WS_QM) + (size_t)row * 768 + col; q[0] = (bf16_t)f2bf(a1 * cs.x - a2 * cs.y); q[4] = (bf16_t)f2bf(a1 * cs.y + a2 * cs.x);
}
__device__ __forceinline__ float blk_max64(float v) { for (int o = 32; o > 0; o >>= 1) v = fmaxf(v, __shfl_xor(v, o)); return v; }
__device__ __forceinline__ float blk_sum64(float v) { for (int o = 32; o > 0; o >>= 1) v += __shfl_xor(v, o); return v; }
__global__ void __launch_bounds__(64) k_mla(Ptrs p) {
    __shared__ float sc[SEQ];
    const int bid = blockIdx.x, t = bid % SEQ, h = (bid / SEQ) % 8, b = bid / (SEQ * 8), tid = threadIdx.x, row = b * SEQ + t;
    const int nk = (t / 64 + 1) * 64;
    const bf16_t* q = (const bf16_t*)(p.ws + WS_QM) + (size_t)row * 768 + 96 * h;
    float mx = -INFINITY;
    for (int s = tid; s < nk; s += 64) { const bf16_t* k = (const bf16_t*)(p.ws + WS_KM) + (size_t)(b * SEQ + s) * 768 + 96 * h; float a = 0.f; for (int d = 0; d < 96; ++d) a += bf2f(q[d]) * bf2f(k[d]); sc[s] = a; mx = fmaxf(mx, a); }
    mx = blk_max64(mx); float l = 0.f;
    for (int s = tid; s < nk; s += 64) { const float e = exp2f(sc[s] - mx); sc[s] = e; l += e; }
    l = blk_sum64(l); __syncthreads();
    float o = 0.f; const bf16_t* v = (const bf16_t*)(p.ws + WS_VM) + (size_t)(b * SEQ) * 512 + 64 * h + tid;
    for (int s = 0; s < nk; ++s) o += sc[s] * bf2f(v[(size_t)s * 512]);
    o /= l;
    const float zg = bf2f(((const bf16_t*)(p.ws + WS_ZG0))[(size_t)row * 1024 + 64 * h + tid]);
    ((bf16_t*)(p.ws + WS_HY))[(size_t)row * 1024 + 64 * h + tid] = (bf16_t)f2bf(o * zg);
}
__global__ void __launch_bounds__(64) k_sb(Ptrs p) {
    __shared__ float sc[SEQ], sp[SEQ];
    const int bid = blockIdx.x, t = bid % SEQ, h = (bid / SEQ) % 8, b = bid / (SEQ * 8), tid = threadIdx.x, row = b * SEQ + t;
    const bf16_t* q = (const bf16_t*)(p.ws + WS_QSB) + (size_t)row * 512 + 64 * h;
    for (int s = tid; s < t; s += 64) { const bf16_t* k = (const bf16_t*)(p.ws + WS_KSB) + (size_t)(b * SEQ + s) * 512 + 64 * h; float a = 0.f; for (int d = 0; d < 64; ++d) a += bf2f(q[d]) * bf2f(k[d]);
        sc[s] = a; sp[s] = fmaxf(a, 0.f) + log2f(1.0f + exp2f(-fabsf(a))); }
    __syncthreads();
    if (tid == 0) { float run = 0.f; for (int s = t - 1; s >= 0; --s) { run += sp[s]; sc[s] = exp2f(sc[s] - run); } }
    __syncthreads();
    float o = 0.f; const bf16_t* v = (const bf16_t*)(p.ws + WS_VSB) + (size_t)(b * SEQ) * 512 + 64 * h + tid;
    for (int s = 0; s < t; ++s) o += sc[s] * bf2f(v[(size_t)s * 512]);
    const float zg = bf2f(((const bf16_t*)(p.ws + WS_ZG0))[(size_t)row * 1024 + 512 + 64 * h + tid]);
    ((bf16_t*)(p.ws + WS_HY))[(size_t)row * 1024 + 512 + 64 * h + tid] = (bf16_t)f2bf(o * zg);
}
__global__ void __launch_bounds__(64) k_diff(Ptrs p) {
    __shared__ float s0[SEQ], s1[SEQ];
    const int bid = blockIdx.x, t = bid % SEQ, h = (bid / SEQ) % 8, b = bid / (SEQ * 8), tid = threadIdx.x, row = b * SEQ + t;
    const int nk = (t / 64 + 1) * 64;
    float d1 = p.lq1[tid] * p.lk1[tid], d2 = p.lq2[tid] * p.lk2[tid]; d1 = blk_sum64(d1); d2 = blk_sum64(d2);
    const float lam = expf(d1) - expf(d2) + LAM_INIT;
    const bf16_t* q = (const bf16_t*)(p.ws + WS_Q1) + (size_t)row * 1024 + 128 * h;
    float m0 = -INFINITY, m1 = -INFINITY;
    for (int s = tid; s < nk; s += 64) { const bf16_t* k = (const bf16_t*)(p.ws + WS_K1) + (size_t)(b * SEQ + s) * 1024 + 128 * h; float a0 = 0.f, a1 = 0.f;
        for (int d = 0; d < 64; ++d) { a0 += bf2f(q[d]) * bf2f(k[d]); a1 += bf2f(q[64 + d]) * bf2f(k[64 + d]); }
        const float bias = p.rel_table[t5_bucket(s - t) * 8 + h] * LOG2E; a0 += bias; a1 += bias; s0[s] = a0; s1[s] = a1; m0 = fmaxf(m0, a0); m1 = fmaxf(m1, a1); }
    m0 = blk_max64(m0); m1 = blk_max64(m1); float l0 = 0.f, l1 = 0.f;
    for (int s = tid; s < nk; s += 64) { const float e0 = exp2f(s0[s] - m0), e1 = exp2f(s1[s] - m1); s0[s] = e0; s1[s] = e1; l0 += e0; l1 += e1; }
    l0 = blk_sum64(l0); l1 = blk_sum64(l1); __syncthreads();
    const float r0 = 1.0f / l0, r1 = lam / l1;
    float oa = 0.f, ob = 0.f; const bf16_t* v = (const bf16_t*)(p.ws + WS_V1) + (size_t)(b * SEQ) * 1024 + 128 * h + tid;
    for (int s = 0; s < nk; ++s) { const float a = s0[s] * r0 - s1[s] * r1; oa += a * bf2f(v[(size_t)s * 1024]); ob += a * bf2f(v[(size_t)s * 1024 + 64]); }
    float ss = blk_sum64(oa * oa + ob * ob); const float rstd = 1.0f / sqrtf(ss / 128.0f + SUBLN_EPS) * (1.0f - LAM_INIT);
    const bf16_t* zg = (const bf16_t*)(p.ws + WS_ZG1) + (size_t)row * 1024 + 128 * h;
    bf16_t* y = (bf16_t*)(p.ws + WS_HY) + (size_t)row * 1024 + 128 * h;
    y[tid] = (bf16_t)f2bf(oa * rstd * p.subln_g[tid] * bf2f(zg[tid])); y[tid + 64] = (bf16_t)f2bf(ob * rstd * p.subln_g[tid + 64] * bf2f(zg[tid + 64]));
}
__global__ void k_final(Ptrs p) {
    __shared__ float red[256];
    const int row = blockIdx.x, tid = threadIdx.x; float* xr = p.out + (size_t)row * D; float v[4], s = 0.f;
    for (int j = 0; j < 4; ++j) { v[j] = xr[tid + 256 * j]; s += v[j] * v[j]; }
    red[tid] = s; __syncthreads();
    for (int o = 128; o > 0; o >>= 1) { if (tid < o) red[tid] += red[tid + o]; __syncthreads(); }
    const float rstd = 1.0f / sqrtf(red[0] / D + NORM_EPS);
    for (int j = 0; j < 4; ++j) xr[tid + 256 * j] = v[j] * rstd * p.final_g[tid + 256 * j];
}

static void run_phase(int ph, const Ptrs& p, hipStream_t st) {
    unsigned char* ws = p.ws;
    switch (ph) {
    case 0: { k_mod<<<(2 * BATCH * MOD_W + 255) / 256, 256, 0, st>>>(p);
              const size_t tot = (size_t)N0P * D + 768 * 384 + 1024 * 256 + (size_t)D * D * 2 + (size_t)DIFF_IN * D; k_wt<<<(unsigned)((tot + 255) / 256), 256, 0, st>>>(p);
              k_rt<<<M * 16 / 256, 256, 0, st>>>(p); } break;
    case 1: k_normmod<<<M, 256, 0, st>>>(p, p.x, 0); break;
    case 2: k_gemm<EG1><<<dim3(N0P / 64, M / 64), 256, 0, st>>>((const bf16_t*)(ws + WS_HY), D, (const bf16_t*)(ws + WS_W0T), M, N0P, D, EG1{ws});
            k_kr<<<M * 16 / 256, 256, 0, st>>>(p); break;
    case 3: k_rstd<<<M / 256, 256, 0, st>>>((const bf16_t*)(ws + WS_CQ), 384, (float*)(ws + WS_RSTD)); k_rstd<<<M / 256, 256, 0, st>>>((const bf16_t*)(ws + WS_CKV), 256, (float*)(ws + WS_RSTD) + M);
            k_gemm<EG2a><<<dim3(768 / 64, M / 64), 256, 0, st>>>((const bf16_t*)(ws + WS_CQ), 384, (const bf16_t*)(ws + WS_WUQT), M, 768, 384, EG2a{ws});
            k_qrope<<<M * 128 / 256, 256, 0, st>>>(p);
            k_gemm<EG2b><<<dim3(1024 / 64, M / 64), 256, 0, st>>>((const bf16_t*)(ws + WS_CKV), 256, (const bf16_t*)(ws + WS_WUKVT), M, 1024, 256, EG2b{ws}); break;
    case 4: k_mla<<<M * 8, 64, 0, st>>>(p); k_sb<<<M * 8, 64, 0, st>>>(p); break;
    case 5: k_gemm<EG3><<<dim3(D / 64, M / 64), 256, 0, st>>>((const bf16_t*)(ws + WS_HY), D, (const bf16_t*)(ws + WS_WO0T), M, D, D, EG3{ws, p.x, p.out, 0}); break;
    case 6: k_normmod<<<M, 256, 0, st>>>(p, p.out, 1); break;
    case 7: k_gemm<EG4><<<dim3(DIFF_IN / 64, M / 64), 256, 0, st>>>((const bf16_t*)(ws + WS_HY), D, (const bf16_t*)(ws + WS_W1T), M, DIFF_IN, D, EG4{ws}); break;
    case 8: k_diff<<<M * 8, 64, 0, st>>>(p); break;
    case 9: k_gemm<EG3><<<dim3(D / 64, M / 64), 256, 0, st>>>((const bf16_t*)(ws + WS_HY), D, (const bf16_t*)(ws + WS_WO1T), M, D, D, EG3{ws, p.out, p.out, 1}); break;
    case 10: k_final<<<M, 256, 0, st>>>(p); break;
    }
}
}
extern "C" void kernel_launch(void* const* d_in, const int* in_sizes, int n_in, void* d_out, int out_size, void* d_ws, size_t ws_size, hipStream_t stream) {
    if (n_in != 21 || out_size != M * D || ws_size < WS_END) { fprintf(stderr, "kernel_launch: unexpected shapes (n_in %d out %d ws %zu)\n", n_in, out_size, ws_size); return; }
    Ptrs p{};
    p.x = (const float*)d_in[0]; p.c = (const float*)d_in[1]; p.pos_offset = (const int*)d_in[2]; p.rel_table = (const float*)d_in[3]; p.ada_w = (const float*)d_in[4]; p.ada_b = (const float*)d_in[5];
    p.norm_g = (const float*)d_in[6]; p.final_g = (const float*)d_in[7]; p.ab_w_in = (const float*)d_in[8]; p.ab_q_norm_g = (const float*)d_in[9]; p.ab_kv_norm_g = (const float*)d_in[10];
    p.ab_w_uq = (const float*)d_in[11]; p.ab_w_ukv = (const float*)d_in[12]; p.ab_w_out = (const float*)d_in[13]; p.dif_w_in = (const float*)d_in[14];
    p.lq1 = (const float*)d_in[15]; p.lk1 = (const float*)d_in[16]; p.lq2 = (const float*)d_in[17]; p.lk2 = (const float*)d_in[18]; p.subln_g = (const float*)d_in[19]; p.dif_w_out = (const float*)d_in[20];
    p.out = (float*)d_out; p.ws = (unsigned char*)d_ws;
    (void)hipMemsetAsync((char*)d_ws + WS_CTL, 0, CTL_ZERO_BYTES, stream);
    for (int ph = 0; ph <= 10; ++ph) nv::run_phase(ph, p, stream);
}
```

```cpp
#define FAST_MASK 0x7FF
#include <hip/hip_runtime.h>
#include <cstdio>
#include <cstdint>
#include <cmath>

typedef unsigned short bf16_t;
#define GAS __attribute__((address_space(1)))
#define LAS __attribute__((address_space(3)))

constexpr int D = 1024, BATCH = 8, SEQ = 2048, M = BATCH * SEQ;
constexpr int MOD_W = 3 * D;
constexpr int AB_IN = 3232, N0P = 3328;
constexpr int DIFF_IN = 4096;
constexpr float LOG2E = 1.4426950408889634f;
constexpr float C_SB = 0.125f * LOG2E;
constexpr float C_MLA = 0.10206207261596577f * LOG2E;
constexpr float LAM_INIT = 0.35550906759096927f;
constexpr float NORM_EPS = 1e-6f, SUBLN_EPS = 1e-5f;

constexpr size_t MiB = 1u << 20;
constexpr size_t WS_CTL = 0, CTL_ZERO_BYTES = 1 * MiB;
constexpr size_t WS_MOD = 512 * 1024;
constexpr size_t WS_W0T = 1 * MiB;
constexpr size_t WS_WUQT = 8 * MiB;
constexpr size_t WS_WUKVT = 9 * MiB;
constexpr size_t WS_WO0T = 10 * MiB;
constexpr size_t WS_W1T = 12 * MiB;
constexpr size_t WS_WO1T = 20 * MiB;
constexpr size_t WS_RT = 22 * MiB;
constexpr size_t WS_HY = 24 * MiB;
constexpr size_t WS_CQ = 56 * MiB;
constexpr size_t WS_CKV = 68 * MiB;
constexpr size_t WS_QSB = 76 * MiB, WS_KSB = 92 * MiB, WS_VSB = 108 * MiB;
constexpr size_t WS_ZG0 = 124 * MiB;
constexpr size_t WS_QM = 156 * MiB, WS_KM = 180 * MiB;
constexpr size_t WS_VM = 204 * MiB;
constexpr size_t WS_RSTD = 220 * MiB;
constexpr size_t WS_Q1 = 56 * MiB, WS_K1 = 88 * MiB, WS_V1 = 120 * MiB, WS_ZG1 = 152 * MiB;
constexpr size_t WS_SSQ = 221 * MiB;
constexpr size_t WS_END = 224 * MiB;

__device__ __forceinline__ unsigned f2bf(float f) { unsigned u = __builtin_bit_cast(unsigned, f); return (u + 0x7fffu + ((u >> 16) & 1u)) >> 16; }
__device__ __forceinline__ float bf2f(unsigned h) { return __builtin_bit_cast(float, h << 16); }
__device__ __forceinline__ unsigned pk2(float lo, float hi) { return f2bf(lo) | (f2bf(hi) << 16); }
__device__ __forceinline__ float silu_f(float v) { return v / (1.0f + __expf(-v)); }
__host__ __device__ __forceinline__ int ropeidx(int p) { const int g = p >> 3, e = p & 7; return e < 4 ? 4 * g + e : 16 + 4 * g + (e - 4); }
__host__ __device__ __forceinline__ int ropeslot(int i) { return 8 * (i >> 2) + (i & 3); }
__host__ __device__ __forceinline__ int t5_bucket(int rel) {
    const int n = rel < 0 ? -rel : rel; int v;
    if (n < 8) v = n; else if (n < 12) v = 8; else if (n < 16) v = 9; else if (n < 23) v = 10; else if (n < 32) v = 11; else if (n < 46) v = 12; else if (n < 64) v = 13; else if (n < 91) v = 14; else v = 15;
    return (rel > 0 ? 16 : 0) + v;
}
__host__ __device__ __forceinline__ int w0_src(int n) {
    if (n < 640) return n;
    if (n < 672) return 640 + ropeidx(n - 640);
    if (n < 768) return -1;
    return n - 96;
}
__host__ __device__ __forceinline__ int wuq_src(int n) { const int h = n / 96, j = n % 96; return j < 64 ? n : 96 * h + 64 + ropeidx(j - 64); }

struct Ptrs {
    const float* x; const float* c; const int* pos_offset; const float* rel_table; const float* ada_w; const float* ada_b; const float* norm_g; const float* final_g;
    const float* ab_w_in; const float* ab_q_norm_g; const float* ab_kv_norm_g; const float* ab_w_uq; const float* ab_w_ukv; const float* ab_w_out;
    const float* dif_w_in; const float* lq1; const float* lk1; const float* lq2; const float* lk2; const float* subln_g; const float* dif_w_out;
    float* out; unsigned char* ws;
};
namespace nv {

__global__ void k_mod(Ptrs p) {
    const int idx = blockIdx.x * blockDim.x + threadIdx.x;
    if (idx >= 2 * BATCH * MOD_W) return;
    const int n = idx % MOD_W, b = (idx / MOD_W) % BATCH, i = idx / (MOD_W * BATCH);
    const float* w = p.ada_w + (size_t)i * D * MOD_W + n; const float* cb = p.c + (size_t)b * D;
    float acc = 0.f;
    for (int k = 0; k < D; ++k) acc += silu_f(cb[k]) * w[(size_t)k * MOD_W];
    ((float*)(p.ws + WS_MOD))[idx] = acc + p.ada_b[i * MOD_W + n];
}
__global__ void k_wt(Ptrs p) {
    const size_t gid = (size_t)blockIdx.x * blockDim.x + threadIdx.x;
    const size_t n0 = (size_t)N0P * D, n1 = (size_t)768 * 384, n2 = (size_t)1024 * 256, n3 = (size_t)D * D, n4 = (size_t)DIFF_IN * D, n5 = (size_t)D * D;
    size_t r = gid;
    if (r < n0) { const int n = (int)(r / D), k = (int)(r % D); const int s = w0_src(n); ((bf16_t*)(p.ws + WS_W0T))[r] = (bf16_t)(s < 0 ? 0u : f2bf(p.ab_w_in[(size_t)k * AB_IN + s])); return; } r -= n0;
    if (r < n1) { const int n = (int)(r / 384), k = (int)(r % 384); ((bf16_t*)(p.ws + WS_WUQT))[r] = (bf16_t)f2bf(p.ab_q_norm_g[k] * p.ab_w_uq[(size_t)k * 768 + wuq_src(n)]); return; } r -= n1;
    if (r < n2) { const int n = (int)(r / 256), k = (int)(r % 256); ((bf16_t*)(p.ws + WS_WUKVT))[r] = (bf16_t)f2bf(p.ab_kv_norm_g[k] * p.ab_w_ukv[(size_t)k * 1024 + n]); return; } r -= n2;
    if (r < n3) { const int n = (int)(r / D), k = (int)(r % D); ((bf16_t*)(p.ws + WS_WO0T))[r] = (bf16_t)f2bf(p.ab_w_out[(size_t)k * D + n]); return; } r -= n3;
    if (r < n4) { const int n = (int)(r / D), k = (int)(r % D); ((bf16_t*)(p.ws + WS_W1T))[r] = (bf16_t)f2bf(p.dif_w_in[(size_t)k * DIFF_IN + n]); return; } r -= n4;
    if (r < n5) { const int n = (int)(r / D), k = (int)(r % D); ((bf16_t*)(p.ws + WS_WO1T))[r] = (bf16_t)f2bf(p.dif_w_out[(size_t)k * D + n]); return; }
}
__global__ void k_rt(Ptrs p) {
    const int idx = blockIdx.x * blockDim.x + threadIdx.x; if (idx >= M * 16) return;
    const int row = idx >> 4, i = idx & 15, b = row / SEQ, t = row % SEQ;
    const float pos = (float)(p.pos_offset[b] + t), inv = powf(10000.0f, -(float)i / 16.0f), ang = pos * inv;
    float s, c; sincosf(ang, &s, &c);
    ((float2*)(p.ws + WS_RT))[idx] = make_float2(c, s);
}
__global__ void k_normmod(Ptrs p, const float* xin, int layer) {
    __shared__ float red[256];
    const int row = blockIdx.x, b = row / SEQ, tid = threadIdx.x;
    const float* xr = xin + (size_t)row * D; float v[4], s = 0.f;
    for (int j = 0; j < 4; ++j) { v[j] = xr[tid + 256 * j]; s += v[j] * v[j]; }
    red[tid] = s; __syncthreads();
    for (int o = 128; o > 0; o >>= 1) { if (tid < o) red[tid] += red[tid + o]; __syncthreads(); }
    const float rstd = 1.0f / sqrtf(red[0] / D + NORM_EPS);
    const float* mod = (const float*)(p.ws + WS_MOD) + (size_t)(layer * BATCH + b) * MOD_W;
    bf16_t* h = (bf16_t*)(p.ws + WS_HY) + (size_t)row * D;
    for (int j = 0; j < 4; ++j) { const int n = tid + 256 * j; h[n] = (bf16_t)f2bf(v[j] * rstd * p.norm_g[layer * D + n] * (1.0f + mod[D + n]) + mod[n]); }
}
template <class Epi> __global__ void __launch_bounds__(256) k_gemm(const bf16_t* A, int lda, const bf16_t* Bt, int Mrows, int N, int K, Epi E) {
    __shared__ __attribute__((aligned(16))) float As[16][68], Bs[16][68];
    const int tid = threadIdx.x, tx = tid & 15, ty = tid >> 4, m0 = blockIdx.y * 64, n0 = blockIdx.x * 64;
    float acc[4][4]; for (int i = 0; i < 4; ++i) for (int j = 0; j < 4; ++j) acc[i][j] = 0.f;
    const int lr = tid >> 2, lk = (tid & 3) * 4;
    for (int k0 = 0; k0 < K; k0 += 16) {
        for (int e = 0; e < 4; ++e) { As[lk + e][lr] = bf2f(A[(size_t)(m0 + lr) * lda + k0 + lk + e]); Bs[lk + e][lr] = bf2f(Bt[(size_t)(n0 + lr) * K + k0 + lk + e]); }
        __syncthreads();
#pragma unroll
        for (int k = 0; k < 16; ++k) { float a[4], b[4];
#pragma unroll
            for (int i = 0; i < 4; ++i) { a[i] = As[k][ty * 4 + i]; b[i] = Bs[k][tx * 4 + i]; }
#pragma unroll
            for (int i = 0; i < 4; ++i)
#pragma unroll
                for (int j = 0; j < 4; ++j) acc[i][j] += a[i] * b[j]; }
        __syncthreads();
    }
#pragma unroll
    for (int i = 0; i < 4; ++i)
#pragma unroll
        for (int j = 0; j < 4; ++j) E(m0 + ty * 4 + i, n0 + tx * 4 + j, acc[i][j]);
}
struct EG1 { unsigned char* ws;
    __device__ void operator()(int row, int col, float v) const {
        if (col < 384) ((bf16_t*)(ws + WS_CQ))[(size_t)row * 384 + col] = (bf16_t)f2bf(v);
        else if (col < 640) ((bf16_t*)(ws + WS_CKV))[(size_t)row * 256 + col - 384] = (bf16_t)f2bf(v);
        else if (col < 768) return;
        else if (col < 1280) ((bf16_t*)(ws + WS_QSB))[(size_t)row * 512 + col - 768] = (bf16_t)f2bf(v * C_SB);
        else if (col < 1792) ((bf16_t*)(ws + WS_KSB))[(size_t)row * 512 + col - 1280] = (bf16_t)f2bf(v);
        else if (col < 2304) ((bf16_t*)(ws + WS_VSB))[(size_t)row * 512 + col - 1792] = (bf16_t)f2bf(v);
        else ((bf16_t*)(ws + WS_ZG0))[(size_t)row * 1024 + col - 2304] = (bf16_t)f2bf(silu_f(v)); } };
struct EG2a { unsigned char* ws;
    __device__ void operator()(int row, int col, float v) const { if (col % 96 >= 64) return;
        ((bf16_t*)(ws + WS_QM))[(size_t)row * 768 + col] = (bf16_t)f2bf(v * ((const float*)(ws + WS_RSTD))[row] * C_MLA); } };
struct EG2b { unsigned char* ws;
    __device__ void operator()(int row, int col, float v) const { const int h = col >> 7, j = col & 127; const float o = v * ((const float*)(ws + WS_RSTD))[M + row];
        if (j < 64) ((bf16_t*)(ws + WS_KM))[(size_t)row * 768 + 96 * h + j] = (bf16_t)f2bf(o); else ((bf16_t*)(ws + WS_VM))[(size_t)row * 512 + 64 * h + j - 64] = (bf16_t)f2bf(o); } };
struct EG3 { unsigned char* ws; const float* xin; float* xout; int layer;
    __device__ void operator()(int row, int col, float v) const { const int b = row / SEQ; const float g = ((const float*)(ws + WS_MOD))[(size_t)(layer * BATCH + b) * MOD_W + 2 * D + col];
        xout[(size_t)row * D + col] = xin[(size_t)row * D + col] + g * v; } };
struct EG4 { unsigned char* ws;
    __device__ void operator()(int row, int col, float v) const {
        if (col < 1024) ((bf16_t*)(ws + WS_Q1))[(size_t)row * 1024 + col] = (bf16_t)f2bf(v * C_SB);
        else if (col < 2048) ((bf16_t*)(ws + WS_K1))[(size_t)row * 1024 + col - 1024] = (bf16_t)f2bf(v);
        else if (col < 3072) ((bf16_t*)(ws + WS_V1))[(size_t)row * 1024 + col - 2048] = (bf16_t)f2bf(v);
        else ((bf16_t*)(ws + WS_ZG1))[(size_t)row * 1024 + col - 3072] = (bf16_t)f2bf(silu_f(v)); } };
__global__ void k_kr(Ptrs p) {
    const int idx = blockIdx.x * blockDim.x + threadIdx.x; if (idx >= M * 16) return;
    const int row = idx >> 4, i = idx & 15, s = ropeslot(i);
    const bf16_t* h = (const bf16_t*)(p.ws + WS_HY) + (size_t)row * D; const bf16_t* w1 = (const bf16_t*)(p.ws + WS_W0T) + (size_t)(640 + s) * D; const bf16_t* w2 = w1 + 4 * D;
    float a1 = 0.f, a2 = 0.f; for (int k = 0; k < D; ++k) { const float hv = bf2f(h[k]); a1 += hv * bf2f(w1[k]); a2 += hv * bf2f(w2[k]); }
    const float2 cs = ((const float2*)(p.ws + WS_RT))[idx]; const float o1 = a1 * cs.x - a2 * cs.y, o2 = a1 * cs.y + a2 * cs.x;
    bf16_t* km = (bf16_t*)(p.ws + WS_KM) + (size_t)row * 768 + 64 + s;
    for (int hh = 0; hh < 8; ++hh) { km[96 * hh] = (bf16_t)f2bf(o1); km[96 * hh + 4] = (bf16_t)f2bf(o2); }
}
__global__ void k_rstd(const bf16_t* src, int W, float* dst) {
    const int row = blockIdx.x * blockDim.x + threadIdx.x; if (row >= M) return;
    float s = 0.f; for (int k = 0; k < W; ++k) { const float v = bf2f(src[(size_t)row * W + k]); s += v * v; }
    dst[row] = 1.0f / sqrtf(s / W + NORM_EPS);
}
__global__ void k_ssqp(Ptrs p) {
    const int row = blockIdx.x * blockDim.x + threadIdx.x; if (row >= M) return;
    float* sq = (float*)(p.ws + WS_SSQ) + (size_t)row * 20; float s = 0.f;
    for (int k = 0; k < 384; ++k) { const float v = bf2f(((const bf16_t*)(p.ws + WS_CQ))[(size_t)row * 384 + k]); s += v * v; }
    sq[0] = s; for (int k = 1; k < 12; ++k) sq[k] = 0.f; s = 0.f;
    for (int k = 0; k < 256; ++k) { const float v = bf2f(((const bf16_t*)(p.ws + WS_CKV))[(size_t)row * 256 + k]); s += v * v; }
    sq[12] = s; for (int k = 13; k < 20; ++k) sq[k] = 0.f;
}
__global__ void k_qrope(Ptrs p) {
    const int idx = blockIdx.x * blockDim.x + threadIdx.x; if (idx >= M * 128) return;
    const int row = idx >> 7, hh = (idx >> 4) & 7, i = idx & 15, s = ropeslot(i), col = 96 * hh + 64 + s;
    const bf16_t* a = (const bf16_t*)(p.ws + WS_CQ) + (size_t)row * 384; const bf16_t* w1 = (const bf16_t*)(p.ws + WS_WUQT) + (size_t)col * 384; const bf16_t* w2 = w1 + 4 * 384;
    float a1 = 0.f, a2 = 0.f; for (int k = 0; k < 384; ++k) { const float av = bf2f(a[k]); a1 += av * bf2f(w1[k]); a2 += av * bf2f(w2[k]); }
    const float sc = ((const float*)(p.ws + WS_RSTD))[row] * C_MLA; a1 *= sc; a2 *= sc;
    const float2 cs = ((const float2*)(p.ws + WS_RT))[row * 16 + i];
    bf16_t* q = (bf16_t*)(p.ws + WS_QM) + (size_t)row * 768 + col; q[0] = (bf16_t)f2bf(a1 * cs.x - a2 * cs.y); q[4] = (bf16_t)f2bf(a1 * cs.y + a2 * cs.x);
}
__device__ __forceinline__ float blk_max64(float v) { for (int o = 32; o > 0; o >>= 1) v = fmaxf(v, __shfl_xor(v, o)); return v; }
__device__ __forceinline__ float blk_sum64(float v) { for (int o = 32; o > 0; o >>= 1) v += __shfl_xor(v, o); return v; }
__global__ void __launch_bounds__(64) k_mla(Ptrs p) {
    __shared__ float sc[SEQ];
    const int bid = blockIdx.x, t = bid % SEQ, h = (bid / SEQ) % 8, b = bid / (SEQ * 8), tid = threadIdx.x, row = b * SEQ + t;
    const int nk = (t / 64 + 1) * 64;
    const bf16_t* q = (const bf16_t*)(p.ws + WS_QM) + (size_t)row * 768 + 96 * h;
    float mx = -INFINITY;
    for (int s = tid; s < nk; s += 64) { const bf16_t* k = (const bf16_t*)(p.ws + WS_KM) + (size_t)(b * SEQ + s) * 768 + 96 * h; float a = 0.f; for (int d = 0; d < 96; ++d) a += bf2f(q[d]) * bf2f(k[d]); sc[s] = a; mx = fmaxf(mx, a); }
    mx = blk_max64(mx); float l = 0.f;
    for (int s = tid; s < nk; s += 64) { const float e = exp2f(sc[s] - mx); sc[s] = e; l += e; }
    l = blk_sum64(l); __syncthreads();
    float o = 0.f; const bf16_t* v = (const bf16_t*)(p.ws + WS_VM) + (size_t)(b * SEQ) * 512 + 64 * h + tid;
    for (int s = 0; s < nk; ++s) o += sc[s] * bf2f(v[(size_t)s * 512]);
    o /= l;
    const float zg = bf2f(((const bf16_t*)(p.ws + WS_ZG0))[(size_t)row * 1024 + 64 * h + tid]);
    ((bf16_t*)(p.ws + WS_HY))[(size_t)row * 1024 + 64 * h + tid] = (bf16_t)f2bf(o * zg);
}
__global__ void __launch_bounds__(64) k_sb(Ptrs p) {
    __shared__ float sc[SEQ], sp[SEQ];
    const int bid = blockIdx.x, t = bid % SEQ, h = (bid / SEQ) % 8, b = bid / (SEQ * 8), tid = threadIdx.x, row = b * SEQ + t;
    const bf16_t* q = (const bf16_t*)(p.ws + WS_QSB) + (size_t)row * 512 + 64 * h;
    for (int s = tid; s < t; s += 64) { const bf16_t* k = (const bf16_t*)(p.ws + WS_KSB) + (size_t)(b * SEQ + s) * 512 + 64 * h; float a = 0.f; for (int d = 0; d < 64; ++d) a += bf2f(q[d]) * bf2f(k[d]);
        sc[s] = a; sp[s] = fmaxf(a, 0.f) + log2f(1.0f + exp2f(-fabsf(a))); }
    __syncthreads();
    if (tid == 0) { float run = 0.f; for (int s = t - 1; s >= 0; --s) { run += sp[s]; sc[s] = exp2f(sc[s] - run); } }
    __syncthreads();
    float o = 0.f; const bf16_t* v = (const bf16_t*)(p.ws + WS_VSB) + (size_t)(b * SEQ) * 512 + 64 * h + tid;
    for (int s = 0; s < t; ++s) o += sc[s] * bf2f(v[(size_t)s * 512]);
    const float zg = bf2f(((const bf16_t*)(p.ws + WS_ZG0))[(size_t)row * 1024 + 512 + 64 * h + tid]);
    ((bf16_t*)(p.ws + WS_HY))[(size_t)row * 1024 + 512 + 64 * h + tid] = (bf16_t)f2bf(o * zg);
}
__global__ void __launch_bounds__(64) k_diff(Ptrs p) {
    __shared__ float s0[SEQ], s1[SEQ];
    const int bid = blockIdx.x, t = bid % SEQ, h = (bid / SEQ) % 8, b = bid / (SEQ * 8), tid = threadIdx.x, row = b * SEQ + t;
    const int nk = (t / 64 + 1) * 64;
    float d1 = p.lq1[tid] * p.lk1[tid], d2 = p.lq2[tid] * p.lk2[tid]; d1 = blk_sum64(d1); d2 = blk_sum64(d2);
    const float lam = expf(d1) - expf(d2) + LAM_INIT;
    const bf16_t* q = (const bf16_t*)(p.ws + WS_Q1) + (size_t)row * 1024 + 128 * h;
    float m0 = -INFINITY, m1 = -INFINITY;
    for (int s = tid; s < nk; s += 64) { const bf16_t* k = (const bf16_t*)(p.ws + WS_K1) + (size_t)(b * SEQ + s) * 1024 + 128 * h; float a0 = 0.f, a1 = 0.f;
        for (int d = 0; d < 64; ++d) { a0 += bf2f(q[d]) * bf2f(k[d]); a1 += bf2f(q[64 + d]) * bf2f(k[64 + d]); }
        const float bias = p.rel_table[t5_bucket(s - t) * 8 + h] * LOG2E; a0 += bias; a1 += bias; s0[s] = a0; s1[s] = a1; m0 = fmaxf(m0, a0); m1 = fmaxf(m1, a1); }
    m0 = blk_max64(m0); m1 = blk_max64(m1); float l0 = 0.f, l1 = 0.f;
    for (int s = tid; s < nk; s += 64) { const float e0 = exp2f(s0[s] - m0), e1 = exp2f(s1[s] - m1); s0[s] = e0; s1[s] = e1; l0 += e0; l1 += e1; }
    l0 = blk_sum64(l0); l1 = blk_sum64(l1); __syncthreads();
    const float r0 = 1.0f / l0, r1 = lam / l1;
    float oa = 0.f, ob = 0.f; const bf16_t* v = (const bf16_t*)(p.ws + WS_V1) + (size_t)(b * SEQ) * 1024 + 128 * h + tid;
    for (int s = 0; s < nk; ++s) { const float a = s0[s] * r0 - s1[s] * r1; oa += a * bf2f(v[(size_t)s * 1024]); ob += a * bf2f(v[(size_t)s * 1024 + 64]); }
    float ss = blk_sum64(oa * oa + ob * ob); const float rstd = 1.0f / sqrtf(ss / 128.0f + SUBLN_EPS) * (1.0f - LAM_INIT);
    const bf16_t* zg = (const bf16_t*)(p.ws + WS_ZG1) + (size_t)row * 1024 + 128 * h;
    bf16_t* y = (bf16_t*)(p.ws + WS_HY) + (size_t)row * 1024 + 128 * h;
    y[tid] = (bf16_t)f2bf(oa * rstd * p.subln_g[tid] * bf2f(zg[tid])); y[tid + 64] = (bf16_t)f2bf(ob * rstd * p.subln_g[tid + 64] * bf2f(zg[tid + 64]));
}
__global__ void k_final(Ptrs p) {
    __shared__ float red[256];
    const int row = blockIdx.x, tid = threadIdx.x; float* xr = p.out + (size_t)row * D; float v[4], s = 0.f;
    for (int j = 0; j < 4; ++j) { v[j] = xr[tid + 256 * j]; s += v[j] * v[j]; }
    red[tid] = s; __syncthreads();
    for (int o = 128; o > 0; o >>= 1) { if (tid < o) red[tid] += red[tid + o]; __syncthreads(); }
    const float rstd = 1.0f / sqrtf(red[0] / D + NORM_EPS);
    for (int j = 0; j < 4; ++j) xr[tid + 256 * j] = v[j] * rstd * p.final_g[tid + 256 * j];
}

static void run_phase(int ph, const Ptrs& p, hipStream_t st) {
    unsigned char* ws = p.ws;
    switch (ph) {
    case 0: { k_mod<<<(2 * BATCH * MOD_W + 255) / 256, 256, 0, st>>>(p);
              const size_t tot = (size_t)N0P * D + 768 * 384 + 1024 * 256 + (size_t)D * D * 2 + (size_t)DIFF_IN * D; k_wt<<<(unsigned)((tot + 255) / 256), 256, 0, st>>>(p);
              k_rt<<<M * 16 / 256, 256, 0, st>>>(p); } break;
    case 1: k_normmod<<<M, 256, 0, st>>>(p, p.x, 0); break;
    case 2: k_gemm<EG1><<<dim3(N0P / 64, M / 64), 256, 0, st>>>((const bf16_t*)(ws + WS_HY), D, (const bf16_t*)(ws + WS_W0T), M, N0P, D, EG1{ws});
            k_kr<<<M * 16 / 256, 256, 0, st>>>(p); break;
    case 3: k_rstd<<<M / 256, 256, 0, st>>>((const bf16_t*)(ws + WS_CQ), 384, (float*)(ws + WS_RSTD)); k_rstd<<<M / 256, 256, 0, st>>>((const bf16_t*)(ws + WS_CKV), 256, (float*)(ws + WS_RSTD) + M);
            k_gemm<EG2a><<<dim3(768 / 64, M / 64), 256, 0, st>>>((const bf16_t*)(ws + WS_CQ), 384, (const bf16_t*)(ws + WS_WUQT), M, 768, 384, EG2a{ws});
            k_qrope<<<M * 128 / 256, 256, 0, st>>>(p);
            k_gemm<EG2b><<<dim3(1024 / 64, M / 64), 256, 0, st>>>((const bf16_t*)(ws + WS_CKV), 256, (const bf16_t*)(ws + WS_WUKVT), M, 1024, 256, EG2b{ws}); break;
    case 4: k_mla<<<M * 8, 64, 0, st>>>(p); k_sb<<<M * 8, 64, 0, st>>>(p); break;
    case 5: k_gemm<EG3><<<dim3(D / 64, M / 64), 256, 0, st>>>((const bf16_t*)(ws + WS_HY), D, (const bf16_t*)(ws + WS_WO0T), M, D, D, EG3{ws, p.x, p.out, 0}); break;
    case 6: k_normmod<<<M, 256, 0, st>>>(p, p.out, 1); break;
    case 7: k_gemm<EG4><<<dim3(DIFF_IN / 64, M / 64), 256, 0, st>>>((const bf16_t*)(ws + WS_HY), D, (const bf16_t*)(ws + WS_W1T), M, DIFF_IN, D, EG4{ws}); break;
    case 8: k_diff<<<M * 8, 64, 0, st>>>(p); break;
    case 9: k_gemm<EG3><<<dim3(D / 64, M / 64), 256, 0, st>>>((const bf16_t*)(ws + WS_HY), D, (const bf16_t*)(ws + WS_WO1T), M, D, D, EG3{ws, p.out, p.out, 1}); break;
    case 10: k_final<<<M, 256, 0, st>>>(p); break;
    }
}
}
namespace pg8 {
#define PG8_LAS __attribute__((address_space(3)))
typedef unsigned short bf16_t;
typedef short bf16x8 __attribute__((ext_vector_type(8)));
typedef float f32x4 __attribute__((ext_vector_type(4)));
typedef unsigned u32x4 __attribute__((ext_vector_type(4)));
constexpr int BM = 256, BK = 64, HALF = 128, HTB = HALF * BK * 2  , STAGE_BYTES = 8 * HTB, NXCD = 8, WGM = 8;

__host__ __device__ __forceinline__ int lds_byte(int r, int c) { const int st = (r >> 4) * 2 + (c >> 5), rr = r & 15, cc = c & 31, ob = rr * 64 + cc * 2; return st * 1024 + (ob ^ (((ob >> 9) & 1) << 5)); }
__host__ __device__ __forceinline__ void stage_rc(int b, int& R, int& C) { const int st = b / 1024, sb = b % 1024, swz = sb ^ (((sb >> 9) & 1) << 5); R = (st >> 1) * 16 + swz / 64; C = (st & 1) * 32 + (swz % 64) / 2; }
__host__ __device__ __forceinline__ int perm32(int rho) { const int n = rho >> 4, i = rho & 15; return 8 * (i >> 2) + 4 * n + (i & 3); }

struct Unit { int pm, pn; };
struct Gemm { const bf16_t* A; const bf16_t* Bt; int M, N, K, lda; };

struct StaticOrder {
    int nM, nN, nwg, G, c;
    __host__ __device__ void init(int M, int N, int G_, int c_) { nM = M / BM; nN = N / BM; nwg = nM * nN; G = G_; c = c_; }
    __host__ __device__ bool next(int i, Unit& u) const {
        const long L = (long)i * G + c; if (L >= nwg) return false;
        int wgid = (int)L; { const int q = nwg / NXCD, r = nwg % NXCD, xcd = wgid % NXCD, off = wgid / NXCD; wgid = (xcd < r ? xcd * (q + 1) : r * (q + 1) + (xcd - r) * q) + off; }
        const int nig = WGM * nN, gid = wgid / nig, fm = gid * WGM, gsz = (nM - fm) < WGM ? (nM - fm) : WGM;
        u.pm = fm + ((wgid % nig) % gsz); u.pn = (wgid % nig) / gsz; return true;
    }
    __device__ __forceinline__ void a_ready(const Unit&) const {}
    __device__ __forceinline__ void done(const Unit&) const {}
};

__device__ __forceinline__ unsigned cvt_pk_bf16(float lo, float hi) { unsigned r; asm volatile("v_cvt_pk_bf16_f32 %0, %1, %2" : "=v"(r) : "v"(lo), "v"(hi)); return r; }
typedef float f32x2 __attribute__((ext_vector_type(2)));
template <class Epi, class Sched, bool ALIGN_EPI = false, bool SP2 = false>
__device__ __forceinline__ void gemm_phase(PG8_LAS unsigned char* lds, const Gemm g, const Sched& S, const Epi& E) {
    const int tid = threadIdx.x, wid = __builtin_amdgcn_readfirstlane(tid >> 6), lane = tid & 63, wr = wid >> 2, wc = wid & 3, fr = lane & 15, fq = lane >> 4;
    int K = g.K; asm volatile("" : "+s"(K)); const int nt = K / BK;
    unsigned voffA[2], voffB[2];
#pragma unroll
    for (int i = 0; i < 2; ++i) { int R, C; stage_rc(tid * 16 + i * 8192, R, C); const int Rb = Epi::PERM ? ((R & ~31) + perm32(R & 31)) : R;
        voffA[i] = (unsigned)(R * g.lda + C) * 2u; voffB[i] = (unsigned)(Rb * K + C) * 2u; }
    const size_t kstep = (size_t)(BK * 2);
    const size_t hstepA = (size_t)HALF * g.lda * 2, hstepB = (size_t)HALF * K * 2;
    const size_t tstepA = 2 * hstepA, tstepB = 2 * hstepB;
    const unsigned ldsw = (unsigned)wid * 1024u;
    const int aoff = lds_byte(wr * 64 + fr, fq * 8), boff = lds_byte(wc * 32 + fr, fq * 8);
#define PG8_SA(b, h) (((b) * 2 + (h)) * HTB)
#define PG8_SB(b, h) ((4 + (b) * 2 + (h)) * HTB)
#define PG8_STAGE(bufoff, gbase, voff) do { _Pragma("unroll") for (int _i = 0; _i < 2; ++_i) \
        __builtin_amdgcn_global_load_lds((const unsigned*)((const char*)(gbase) + (voff)[_i]), (PG8_LAS unsigned*)(lds + (bufoff) + ldsw + _i * 8192), 16, 0, 0); } while (0)
#define PG8_LDA(dst, b, h) do { _Pragma("unroll") for (int m = 0; m < 4; ++m) _Pragma("unroll") for (int k = 0; k < 2; ++k) dst[m][k] = *(const PG8_LAS bf16x8*)(lds + PG8_SA(b, h) + aoff + m * 2048 + k * 1024); } while (0)
#define PG8_LDB(dst, b, h) do { _Pragma("unroll") for (int n = 0; n < 2; ++n) _Pragma("unroll") for (int k = 0; k < 2; ++k) dst[n][k] = *(const PG8_LAS bf16x8*)(lds + PG8_SB(b, h) + boff + n * 2048 + k * 1024); } while (0)
#define PG8_MMA(ai, bj, At, Bt) do { __builtin_amdgcn_s_setprio(1); _Pragma("unroll") for (int m = 0; m < 4; ++m) _Pragma("unroll") for (int n = 0; n < 2; ++n) _Pragma("unroll") for (int k = 0; k < 2; ++k) \
        acc[ai][bj][m][n] = __builtin_amdgcn_mfma_f32_16x16x32_bf16(Bt[n][k], At[m][k], acc[ai][bj][m][n], 0, 0, 0); __builtin_amdgcn_s_setprio(0); } while (0)
#define PG8_WAIT_V(n) asm volatile("s_waitcnt vmcnt(" #n ")" ::: "memory")
#define PG8_WAIT_L(n) asm volatile("s_waitcnt lgkmcnt(" #n ")" ::: "memory")
#define PG8_BAR __builtin_amdgcn_s_barrier()
#define PG8_SCHED __builtin_amdgcn_sched_barrier(0)
    Unit cur, nxt; int ui = 0;
    if (!S.next(0, cur)) return;
    f32x4 acc[2][2][4][2];
#pragma unroll
    for (int a = 0; a < 2; ++a)
#pragma unroll
        for (int b = 0; b < 2; ++b)
#pragma unroll
            for (int m = 0; m < 4; ++m)
#pragma unroll
                for (int n = 0; n < 2; ++n) acc[a][b][m][n] = (f32x4){0.f, 0.f, 0.f, 0.f};
    bf16x8 At[4][2], B0[2][2], B1[2][2];
    const char* cA = (const char*)g.A + (size_t)cur.pm * tstepA; const char* cB = (const char*)g.Bt + (size_t)cur.pn * tstepB;
    S.a_ready(cur);
    if constexpr (SP2) {
        PG8_STAGE(PG8_SB(0, 0), cB, voffB); PG8_STAGE(PG8_SB(0, 1), cB + hstepB, voffB); PG8_STAGE(PG8_SA(0, 0), cA, voffA); PG8_STAGE(PG8_SA(0, 1), cA + hstepA, voffA);
        if (wr == 1) PG8_BAR;
        PG8_WAIT_V(2); PG8_BAR;
        PG8_STAGE(PG8_SB(1, 0), cB + kstep, voffB); PG8_STAGE(PG8_SA(1, 0), cA + kstep, voffA); PG8_STAGE(PG8_SB(1, 1), cB + hstepB + kstep, voffB);
        PG8_WAIT_V(6); PG8_BAR;
    } else {
        PG8_STAGE(PG8_SB(0, 0), cB, voffB); PG8_STAGE(PG8_SA(0, 0), cA, voffA); PG8_STAGE(PG8_SB(0, 1), cB + hstepB, voffB); PG8_STAGE(PG8_SA(0, 1), cA + hstepA, voffA);
        if (wr == 1) PG8_BAR;
        PG8_WAIT_V(4); PG8_BAR;
        PG8_STAGE(PG8_SB(1, 0), cB + kstep, voffB); PG8_STAGE(PG8_SA(1, 0), cA + kstep, voffA); PG8_STAGE(PG8_SB(1, 1), cB + hstepB + kstep, voffB);
        PG8_WAIT_V(6); PG8_BAR;
    }
    for (;;) {
        const bool has_next = S.next(ui + 1, nxt);
        const char* nA = has_next ? (const char*)g.A + (size_t)nxt.pm * tstepA : cA; const char* nB = has_next ? (const char*)g.Bt + (size_t)nxt.pn * tstepB : cB;
        for (int t = 0; t < nt; t += 2) {
            const bool last = (t == nt - 2);
            const char* a1 = cA + (size_t)(t + 1) * kstep;
            const char* a2 = last ? nA : cA + (size_t)(t + 2) * kstep; const char* b2 = last ? nB : cB + (size_t)(t + 2) * kstep;
            const char* a3 = a2 + kstep; const char* b3 = b2 + kstep;
            if (last && has_next) S.a_ready(nxt);
            if constexpr (SP2) {
            PG8_LDB(B0, 0, 0); PG8_LDB(B1, 0, 1); PG8_SCHED; PG8_LDA(At, 0, 0); PG8_STAGE(PG8_SA(1, 1), a1 + hstepA, voffA);
            PG8_WAIT_V(8); PG8_WAIT_L(0); PG8_BAR; PG8_MMA(0, 0, At, B0); PG8_MMA(0, 1, At, B1); PG8_BAR; PG8_SCHED;
            PG8_LDA(At, 0, 1); PG8_STAGE(PG8_SB(0, 0), b2, voffB); PG8_STAGE(PG8_SB(0, 1), b2 + hstepB, voffB); PG8_STAGE(PG8_SA(0, 0), a2, voffA);
            PG8_WAIT_V(8); PG8_WAIT_L(0); PG8_BAR; PG8_MMA(1, 0, At, B0); PG8_MMA(1, 1, At, B1); PG8_BAR; PG8_SCHED;
            PG8_LDB(B0, 1, 0); PG8_LDB(B1, 1, 1); PG8_SCHED; PG8_LDA(At, 1, 0); PG8_STAGE(PG8_SA(0, 1), a2 + hstepA, voffA);
            PG8_WAIT_V(8); PG8_WAIT_L(0); PG8_BAR; PG8_MMA(0, 0, At, B0); PG8_MMA(0, 1, At, B1); PG8_BAR; PG8_SCHED;
            PG8_LDA(At, 1, 1); PG8_STAGE(PG8_SB(1, 0), b3, voffB); PG8_STAGE(PG8_SB(1, 1), b3 + hstepB, voffB); PG8_STAGE(PG8_SA(1, 0), a3, voffA);
            PG8_WAIT_V(8); PG8_WAIT_L(0); PG8_BAR; PG8_MMA(1, 0, At, B0); PG8_MMA(1, 1, At, B1); PG8_BAR; PG8_SCHED;
            } else {
            PG8_LDB(B0, 0, 0); PG8_SCHED; PG8_LDA(At, 0, 0); PG8_STAGE(PG8_SA(1, 1), a1 + hstepA, voffA);
            PG8_WAIT_L(8); PG8_BAR; PG8_WAIT_L(0); PG8_MMA(0, 0, At, B0); PG8_BAR; PG8_SCHED;
            PG8_LDB(B1, 0, 1); PG8_STAGE(PG8_SB(0, 0), b2, voffB);
            PG8_BAR; PG8_WAIT_L(0); PG8_MMA(0, 1, At, B1); PG8_BAR;
            PG8_LDA(At, 0, 1); PG8_STAGE(PG8_SA(0, 0), a2, voffA);
            PG8_BAR; PG8_WAIT_L(0); PG8_MMA(1, 0, At, B0); PG8_BAR; PG8_SCHED;
            PG8_STAGE(PG8_SB(0, 1), b2 + hstepB, voffB);
            PG8_WAIT_V(6); PG8_BAR; PG8_MMA(1, 1, At, B1); PG8_BAR;
            PG8_LDB(B0, 1, 0); PG8_SCHED; PG8_LDA(At, 1, 0); PG8_STAGE(PG8_SA(0, 1), a2 + hstepA, voffA);
            PG8_WAIT_L(8); PG8_BAR; PG8_WAIT_L(0); PG8_MMA(0, 0, At, B0); PG8_BAR; PG8_SCHED;
            PG8_LDB(B1, 1, 1); PG8_STAGE(PG8_SB(1, 0), b3, voffB);
            PG8_BAR; PG8_WAIT_L(0); PG8_MMA(0, 1, At, B1); PG8_BAR;
            PG8_LDA(At, 1, 1); PG8_STAGE(PG8_SA(1, 0), a3, voffA);
            PG8_BAR; PG8_WAIT_L(0); PG8_MMA(1, 0, At, B0); PG8_BAR; PG8_SCHED;
            PG8_STAGE(PG8_SB(1, 1), b3 + hstepB, voffB);
            PG8_WAIT_V(6); PG8_BAR; PG8_MMA(1, 1, At, B1); PG8_BAR;
            }
        }
        if constexpr (ALIGN_EPI) { if (wr == 0) PG8_BAR; }
        if constexpr (!Epi::AFTER_DRAIN) { E(acc, cur, wr, wc, fr, fq); S.done(cur); }
        if (!has_next) break;
#pragma unroll
        for (int a = 0; a < 2; ++a)
#pragma unroll
            for (int b = 0; b < 2; ++b)
#pragma unroll
                for (int m = 0; m < 4; ++m)
#pragma unroll
                    for (int n = 0; n < 2; ++n) acc[a][b][m][n] = (f32x4){0.f, 0.f, 0.f, 0.f};
        cur = nxt; cA = nA; cB = nB; ++ui;
        if constexpr (ALIGN_EPI) { if (wr == 1) PG8_BAR; }
    }
    PG8_WAIT_V(0);
    if constexpr (!ALIGN_EPI) { if (wr == 0) PG8_BAR; }
    PG8_BAR;
    if constexpr (Epi::AFTER_DRAIN) { E.fused(acc, cur, wr, wc, fr, fq, lds, wid, lane); S.done(cur); }
#undef PG8_SA
#undef PG8_SB
#undef PG8_STAGE
#undef PG8_LDA
#undef PG8_LDB
#undef PG8_MMA
#undef PG8_WAIT_V
#undef PG8_WAIT_L
#undef PG8_BAR
#undef PG8_SCHED
}
}
#define GAS __attribute__((address_space(1)))
#define LAS __attribute__((address_space(3)))
typedef unsigned short bf16;
typedef unsigned v4u __attribute__((ext_vector_type(4)));
typedef float f32x4 __attribute__((ext_vector_type(4)));
typedef short bf16x8 __attribute__((ext_vector_type(8)));
typedef GAS unsigned gu32;
typedef GAS unsigned long long gu64;
#define RLX_AGENT __ATOMIC_RELAXED, __HIP_MEMORY_SCOPE_AGENT
#define LDS_WAIT() asm volatile("s_waitcnt lgkmcnt(0)" ::: "memory")
#define VM_WAIT() asm volatile("s_waitcnt vmcnt(0)" ::: "memory")
__device__ __forceinline__ unsigned long long rt() { return __builtin_amdgcn_s_memrealtime(); }

#define XB_TMO      128
#define XB_XCNT(j)  (256  + 64 * (j))
#define XB_XSUB(j)  (1280 + 64 * (j))
#define XB_XGEN(j)  (2304 + 64 * (j))
#define XB_TOP      3328
#define XB_TOPGEN   3392
#define XCD_BAR_WORDS 3456
#define XB_SPIN_CAP (1u << 18)

__device__ __forceinline__ unsigned xb_ld(unsigned* p)              { return __hip_atomic_load(p, __ATOMIC_RELAXED, __HIP_MEMORY_SCOPE_AGENT); }
__device__ __forceinline__ unsigned xb_add(unsigned* p, unsigned v) { return __hip_atomic_fetch_add(p, v, __ATOMIC_RELAXED, __HIP_MEMORY_SCOPE_AGENT); }
__device__ __forceinline__ unsigned xb_xcc_id() { return (unsigned)__builtin_amdgcn_s_getreg((3 << 11) | 20) & 0xFu; }
#define XB_SPIN(cond, bar) do { unsigned _sp = 0; while (cond) { __builtin_amdgcn_s_sleep(1); \
    if ((++_sp & 255u) == 0u) { if (xb_ld(&(bar)[XB_TMO])) break; if (_sp > XB_SPIN_CAP) { atomicAdd(&(bar)[XB_TMO], 1u); break; } } } } while (0)

struct XcdBarrier {
    unsigned* bar; unsigned x;
    volatile LAS unsigned* st;
};

__device__ __forceinline__ XcdBarrier xcd_barrier_post(unsigned* bar, volatile LAS unsigned* st) {
    XcdBarrier b; b.bar = bar; b.x = xb_xcc_id(); b.st = st;
    if (threadIdx.x == 0) (void)xb_add(&bar[XB_XCNT(b.x)], 1u);
    return b;
}
__device__ __forceinline__ void xcd_barrier_complete(unsigned* bar, unsigned x, unsigned& nloc, unsigned& nx) {
    const unsigned G = gridDim.x * gridDim.y * gridDim.z;
    unsigned sum, cnt, mine, sp = 0u;
    for (;;) {
        sum = 0u; cnt = 0u; mine = 0u;
#pragma unroll
        for (unsigned j = 0; j < 16; ++j) { const unsigned c = xb_ld(&bar[XB_XCNT(j)]); sum += c; cnt += (c > 0u) ? 1u : 0u; mine = (j == x) ? c : mine; }
        if (sum == G) break;
        __builtin_amdgcn_s_sleep(1);
        if ((++sp & 255u) == 0u) { if (xb_ld(&bar[XB_TMO])) break; if (sp > XB_SPIN_CAP) { atomicAdd(&bar[XB_TMO], 1u); break; } }
    }
    nloc = mine > 0u ? mine : 1u; nx = cnt > 0u ? cnt : 1u;
}

__device__ __forceinline__ void xcd_barrier(const XcdBarrier& b) {
    asm volatile("s_waitcnt vmcnt(0)" ::: "memory");
    __syncthreads();
    if (threadIdx.x == 0) {
        unsigned* bar = b.bar;
        __builtin_amdgcn_s_waitcnt(0);
        unsigned nloc = b.st[0], nx = b.st[1];
        if (nloc == 0u) { xcd_barrier_complete(bar, b.x, nloc, nx); b.st[0] = nloc; b.st[1] = nx; }
        const unsigned old = xb_add(&bar[XB_XSUB(b.x)], 1u);
        const unsigned gen = old / nloc;
        if (old + 1u == (gen + 1u) * nloc) {
            __builtin_amdgcn_fence(__ATOMIC_RELEASE, "agent");
            asm volatile("s_waitcnt vmcnt(0)" ::: "memory");
            const unsigned og = xb_add(&bar[XB_TOP], 1u);
            const unsigned tg = og / nx;
            if (og + 1u == (tg + 1u) * nx) xb_add(&bar[XB_TOPGEN], 1u);
            else XB_SPIN(xb_ld(&bar[XB_TOPGEN]) == tg, bar);
            __builtin_amdgcn_fence(__ATOMIC_ACQUIRE, "agent");
            xb_add(&bar[XB_XGEN(b.x)], 1u);
            asm volatile("s_waitcnt vmcnt(0)" ::: "memory");
        } else {
            XB_SPIN(xb_ld(&bar[XB_XGEN(b.x)]) == gen, bar);
            __builtin_amdgcn_fence(__ATOMIC_ACQUIRE, "agent");
            asm volatile("s_waitcnt vmcnt(0)" ::: "memory");
        }
    }
    __syncthreads();
}
constexpr int NWAVES = 8;
constexpr int RING_OFF = 0, RING_BYTES = 131072;
constexpr int LDSCTL_OFF = RING_BYTES, MISC_OFF = LDSCTL_OFF + 320;
constexpr int LDS_BYTES = 147456;
constexpr int CW_BAR = 4096;

namespace pg8 {
typedef unsigned u32x2 __attribute__((ext_vector_type(2)));
__device__ __forceinline__ float fast_silu(float v) { return v * __builtin_amdgcn_rcpf(1.0f + __expf(-v)); }
__device__ __forceinline__ u32x4 pack8(f32x4 a, f32x4 b) { u32x4 w; w.x = cvt_pk_bf16(a[0], a[1]); w.y = cvt_pk_bf16(a[2], a[3]); w.z = cvt_pk_bf16(b[0], b[1]); w.w = cvt_pk_bf16(b[2], b[3]); return w; }
__device__ __forceinline__ void rope4(const unsigned char* ws, int row, int i0, f32x4& x1, f32x4& x2) {
    const f32x4* rt = (const f32x4*)(ws + WS_RT) + ((size_t)row * 16 + i0) / 2;
    const f32x4 a = rt[0], b = rt[1];
    const f32x4 c = {a[0], a[2], b[0], b[2]}, s = {a[1], a[3], b[1], b[3]};
    const f32x4 o1 = x1 * c - x2 * s, o2 = x1 * s + x2 * c; x1 = o1; x2 = o2;
}
struct EpiG1 {
    static constexpr bool PERM = true, AFTER_DRAIN = false; unsigned char* ws;
    __device__ __forceinline__ void operator()(const f32x4 (&acc)[2][2][4][2], const Unit& u, int wr, int wc, int fr, int fq) const {
        const int row0 = u.pm * BM + wr * 64 + fr;
#pragma unroll
        for (int bj = 0; bj < 2; ++bj) {
            const int beta = 2 * u.pn + bj, cb = 32 * wc + 8 * fq;
            bf16_t* dst = nullptr; int ldc = 0, dcol = 0, kind = 0, slot = -1;
            if (beta < 3) { dst = (bf16_t*)(ws + WS_CQ); ldc = 384; dcol = 128 * beta + cb; slot = 4 * beta + wc; }
            else if (beta < 5) { dst = (bf16_t*)(ws + WS_CKV); ldc = 256; dcol = 128 * (beta - 3) + cb; slot = 12 + 4 * (beta - 3) + wc; }
            else if (beta == 5) { kind = (wc == 0) ? 3 : 4; }
            else if (beta < 10) { dst = (bf16_t*)(ws + WS_QSB); ldc = 512; dcol = 128 * (beta - 6) + cb; kind = 1; }
            else if (beta < 14) { dst = (bf16_t*)(ws + WS_KSB); ldc = 512; dcol = 128 * (beta - 10) + cb; }
            else if (beta < 18) { dst = (bf16_t*)(ws + WS_VSB); ldc = 512; dcol = 128 * (beta - 14) + cb; }
            else { dst = (bf16_t*)(ws + WS_ZG0); ldc = 1024; dcol = 128 * (beta - 18) + cb; kind = 2; }
            if (kind == 4) continue;
#pragma unroll
            for (int ai = 0; ai < 2; ++ai)
#pragma unroll
                for (int m = 0; m < 4; ++m) {
                    const int row = row0 + ai * HALF + m * 16; f32x4 v0 = acc[ai][bj][m][0], v1 = acc[ai][bj][m][1];
                    if (kind == 3) {
                        rope4(ws, row, 4 * fq, v0, v1); const u32x4 w = pack8(v0, v1);
                        bf16_t* km = (bf16_t*)(ws + WS_KM) + (size_t)row * 768 + 64 + 8 * fq;
#pragma unroll
                        for (int hh = 0; hh < 8; ++hh) *(u32x4*)(km + 96 * hh) = w;
                        continue;
                    }
                    if (slot >= 0) { float s = (v0[0] * v0[0] + v0[1] * v0[1]) + (v0[2] * v0[2] + v0[3] * v0[3]) + (v1[0] * v1[0] + v1[1] * v1[1]) + (v1[2] * v1[2] + v1[3] * v1[3]);
                        s += __shfl_xor(s, 16); s += __shfl_xor(s, 32); if (fq == 0) ((float*)(ws + WS_SSQ))[(size_t)row * 20 + slot] = s; }
                    if (kind == 1) { v0 = v0 * C_SB; v1 = v1 * C_SB; }
                    if (kind == 2) {
#pragma unroll
                        for (int e = 0; e < 4; ++e) { v0[e] = fast_silu(v0[e]); v1[e] = fast_silu(v1[e]); } }
                    *(u32x4*)(dst + (size_t)row * ldc + dcol) = pack8(v0, v1);
                }
        }
    }
};
struct EpiUQ {
    static constexpr bool PERM = true, AFTER_DRAIN = false; unsigned char* ws;
    __device__ __forceinline__ void operator()(const f32x4 (&acc)[2][2][4][2], const Unit& u, int wr, int wc, int fr, int fq) const {
        const int row0 = u.pm * BM + wr * 64 + fr;
#pragma unroll
        for (int ai = 0; ai < 2; ++ai)
#pragma unroll
            for (int m = 0; m < 4; ++m) {
                int row = row0 + ai * HALF + m * 16; asm volatile("" : "+v"(row));
                const f32x4* sq = (const f32x4*)((const float*)(ws + WS_SSQ) + (size_t)row * 20); const f32x4 a = sq[0], b = sq[1], c = sq[2];
                const float ssq = ((a[0] + a[1]) + (a[2] + a[3])) + ((b[0] + b[1]) + (b[2] + b[3])) + ((c[0] + c[1]) + (c[2] + c[3]));
                const float sc = C_MLA / sqrtf(ssq * (1.0f / 384.0f) + NORM_EPS);
#pragma unroll
                for (int bj = 0; bj < 2; ++bj) {
                    const int c0 = u.pn * BM + bj * HALF + 32 * wc + 8 * fq, hh = c0 / 96, j = c0 - 96 * hh;
                    f32x4 v0 = acc[ai][bj][m][0] * sc, v1 = acc[ai][bj][m][1] * sc;
                    if (j >= 64) rope4(ws, row, 4 * ((j - 64) >> 3), v0, v1);
                    *(u32x4*)((bf16_t*)(ws + WS_QM) + (size_t)row * 768 + c0) = pack8(v0, v1);
                }
                asm volatile("" ::: "memory");
            }
    }
};
struct EpiUKV {
    static constexpr bool PERM = true, AFTER_DRAIN = false; unsigned char* ws;
    __device__ __forceinline__ void operator()(const f32x4 (&acc)[2][2][4][2], const Unit& u, int wr, int wc, int fr, int fq) const {
        const int row0 = u.pm * BM + wr * 64 + fr, jj = 32 * wc + 8 * fq;
#pragma unroll
        for (int ai = 0; ai < 2; ++ai)
#pragma unroll
            for (int m = 0; m < 4; ++m) {
                int row = row0 + ai * HALF + m * 16; asm volatile("" : "+v"(row));
                const f32x4* sq = (const f32x4*)((const float*)(ws + WS_SSQ) + (size_t)row * 20 + 12); const f32x4 a = sq[0], b = sq[1];
                const float ssq = ((a[0] + a[1]) + (a[2] + a[3])) + ((b[0] + b[1]) + (b[2] + b[3]));
                const float sc = 1.0f / sqrtf(ssq * (1.0f / 256.0f) + NORM_EPS);
#pragma unroll
                for (int bj = 0; bj < 2; ++bj) {
                    const int hh = 2 * u.pn + bj;
                    bf16_t* dst = (wc < 2) ? (bf16_t*)(ws + WS_KM) + (size_t)row * 768 + 96 * hh + jj : (bf16_t*)(ws + WS_VM) + (size_t)row * 512 + 64 * hh + (jj - 64);
                    *(u32x4*)dst = pack8(acc[ai][bj][m][0] * sc, acc[ai][bj][m][1] * sc);
                }
                asm volatile("" ::: "memory");
            }
    }
};
struct EpiOut {
    static constexpr bool PERM = false, AFTER_DRAIN = false; const float* xin; float* xout; const float* gate;
    __device__ __forceinline__ void operator()(const f32x4 (&acc)[2][2][4][2], const Unit& u, int wr, int wc, int fr, int fq) const {
        const int row0 = u.pm * BM + wr * 64 + fr, b = (u.pm * BM) / SEQ, col0 = u.pn * BM + wc * 32 + 4 * fq;
        f32x4 gv[2][2];
#pragma unroll
        for (int bj = 0; bj < 2; ++bj)
#pragma unroll
            for (int n = 0; n < 2; ++n) gv[bj][n] = *(const f32x4*)(gate + (size_t)b * MOD_W + col0 + bj * HALF + n * 16);
#pragma unroll
        for (int ai = 0; ai < 2; ++ai)
#pragma unroll
            for (int m = 0; m < 4; ++m) { const size_t off = (size_t)(row0 + ai * HALF + m * 16) * D + col0;
#pragma unroll
                for (int bj = 0; bj < 2; ++bj)
#pragma unroll
                    for (int n = 0; n < 2; ++n) { const f32x4 xv = *(const f32x4*)(xin + off + bj * HALF + n * 16); *(f32x4*)(xout + off + bj * HALF + n * 16) = xv + gv[bj][n] * acc[ai][bj][m][n]; } }
    }
};
struct EpiG4 {
    static constexpr bool PERM = true, AFTER_DRAIN = false; unsigned char* ws;
    __device__ __forceinline__ void operator()(const f32x4 (&acc)[2][2][4][2], const Unit& u, int wr, int wc, int fr, int fq) const {
        const int row0 = u.pm * BM + wr * 64 + fr, which = u.pn >> 2;
        bf16_t* dst = (bf16_t*)(ws + (which == 0 ? WS_Q1 : which == 1 ? WS_K1 : which == 2 ? WS_V1 : WS_ZG1));
#pragma unroll
        for (int bj = 0; bj < 2; ++bj) { const int dcol = 256 * (u.pn & 3) + bj * HALF + 32 * wc + 8 * fq;
#pragma unroll
            for (int ai = 0; ai < 2; ++ai)
#pragma unroll
                for (int m = 0; m < 4; ++m) { const int row = row0 + ai * HALF + m * 16; f32x4 v0 = acc[ai][bj][m][0], v1 = acc[ai][bj][m][1];
                    if (which == 0) { v0 = v0 * C_SB; v1 = v1 * C_SB; }
                    if (which == 3) {
#pragma unroll
                        for (int e = 0; e < 4; ++e) { v0[e] = fast_silu(v0[e]); v1[e] = fast_silu(v1[e]); } }
                    *(u32x4*)(dst + (size_t)row * 1024 + dcol) = pack8(v0, v1); } }
    }
};
}

struct Frame { LAS unsigned char* lds; volatile LAS unsigned* MISC; gu32* ctl; int tid, lane, wave, vcu, G; };
__device__ __forceinline__ float wave_sum(float v) {
#pragma unroll
    for (int o = 1; o < 64; o <<= 1) v += __shfl_xor(v, o);
    return v;
}
__device__ __forceinline__ int msrc(int mat, int n) { return mat == 0 ? w0_src(n) : mat == 1 ? wuq_src(n) : n; }
__device__ __forceinline__ void p0_transpose_item(const float* W, int K, int Nsrc, bf16_t* WT, int Nout, int mat, const float* rowscale, LAS float* scr, int item, int lane) {
    const int nblk = Nout / 32, kb = item / nblk, nb = item % nblk, k0 = 64 * kb, n0 = 32 * nb;
    const int s = msrc(mat, n0 + (lane & 31));
#pragma unroll 8
    for (int i = 0; i < 32; ++i) { const int kk = 2 * i + (lane >> 5); float v = 0.f; if (s >= 0) { v = W[(size_t)(k0 + kk) * Nsrc + s]; if (rowscale) v *= rowscale[k0 + kk]; } scr[kk * 33 + (lane & 31)] = v; }
    LDS_WAIT(); asm volatile("" ::: "memory");
    const int c = lane & 7;
#pragma unroll
    for (int j = 0; j < 4; ++j) { const int n = (lane >> 3) + 8 * j; const LAS float* sp = scr + (8 * c) * 33 + n;
        v4u o; o.x = pk2(sp[0 * 33], sp[1 * 33]); o.y = pk2(sp[2 * 33], sp[3 * 33]); o.z = pk2(sp[4 * 33], sp[5 * 33]); o.w = pk2(sp[6 * 33], sp[7 * 33]);
        *(GAS v4u*)(WT + (size_t)(n0 + n) * K + k0 + 8 * c) = o; }
    LDS_WAIT(); asm volatile("" ::: "memory");
}
__device__ __forceinline__ void p0_prologue(Frame& F, const Ptrs& p) {
    const int gw = F.vcu * NWAVES + F.wave, NGW = F.G * NWAVES, lane = F.lane;
    float* MOD = (float*)(p.ws + WS_MOD);
    for (int it = gw; it < 2 * 48 * 16; it += NGW) {
        const int i = it / 768, r = it % 768, n0 = (r >> 4) * 64, ks = r & 15, k0 = ks * 64;
        float sc[8], acc[8];
#pragma unroll
        for (int b = 0; b < 8; ++b) { sc[b] = silu_f(p.c[b * D + k0 + lane]); acc[b] = 0.f; }
        const float* w = p.ada_w + ((size_t)i * D + k0) * MOD_W + n0 + lane;
#pragma unroll 8
        for (int kk = 0; kk < 64; ++kk) { const float wv = w[(size_t)kk * MOD_W];
#pragma unroll
            for (int b = 0; b < 8; ++b) acc[b] += __builtin_bit_cast(float, __builtin_amdgcn_readlane(__builtin_bit_cast(int, sc[b]), kk)) * wv; }
        const float bias = (ks == 0) ? p.ada_b[i * MOD_W + n0 + lane] : 0.f;
#pragma unroll
        for (int b = 0; b < 8; ++b) atomicAdd(MOD + (size_t)(i * BATCH + b) * MOD_W + n0 + lane, acc[b] + bias);
    }
    LAS float* scr = (LAS float*)(F.lds + RING_OFF + F.wave * 16384);
    constexpr int I0 = 16 * (N0P / 32), I1 = 6 * 24, I2 = 4 * 32, I3 = 16 * 32, I4 = 16 * (DIFF_IN / 32), I5 = 16 * 32, NIT = I0 + I1 + I2 + I3 + I4 + I5;
    for (int it = gw; it < NIT; it += NGW) {
        int r = it;
        if (r < I0) { p0_transpose_item(p.ab_w_in, D, AB_IN, (bf16_t*)(p.ws + WS_W0T), N0P, 0, nullptr, scr, r, lane); continue; } r -= I0;
        if (r < I1) { p0_transpose_item(p.ab_w_uq, 384, 768, (bf16_t*)(p.ws + WS_WUQT), 768, 1, p.ab_q_norm_g, scr, r, lane); continue; } r -= I1;
        if (r < I2) { p0_transpose_item(p.ab_w_ukv, 256, 1024, (bf16_t*)(p.ws + WS_WUKVT), 1024, 2, p.ab_kv_norm_g, scr, r, lane); continue; } r -= I2;
        if (r < I3) { p0_transpose_item(p.ab_w_out, D, D, (bf16_t*)(p.ws + WS_WO0T), D, 2, nullptr, scr, r, lane); continue; } r -= I3;
        if (r < I4) { p0_transpose_item(p.dif_w_in, D, DIFF_IN, (bf16_t*)(p.ws + WS_W1T), DIFF_IN, 2, nullptr, scr, r, lane); continue; } r -= I4;
        p0_transpose_item(p.dif_w_out, D, D, (bf16_t*)(p.ws + WS_WO1T), D, 2, nullptr, scr, r, lane);
    }
    for (int idx = F.vcu * NWAVES * 64 + F.tid; idx < M * 16; idx += F.G * NWAVES * 64) {
        const int row = idx >> 4, i = idx & 15, b = row / SEQ, t = row % SEQ;
        const float pos = (float)(p.pos_offset[b] + t), inv = powf(10000.0f, -(float)i / 16.0f), ang = pos * inv;
        float s, c; sincosf(ang, &s, &c);
        ((float2*)(p.ws + WS_RT))[idx] = make_float2(c, s);
    }
}
__device__ __forceinline__ void normmod_phase(Frame& F, const Ptrs& p, const float* xin, int layer) {
    const int gw = F.vcu * NWAVES + F.wave, NGW = F.G * NWAVES, lane = F.lane;
    const float* MOD = (const float*)(p.ws + WS_MOD);
    for (int rg = gw; rg < M / 8; rg += NGW) {
        const int b = (rg * 8) / SEQ; const float* mod = MOD + (size_t)(layer * BATCH + b) * MOD_W;
        f32x4 gs[4], sh[4];
#pragma unroll
        for (int j = 0; j < 4; ++j) { const int c = 4 * lane + 256 * j; const f32x4 g = *(const f32x4*)(p.norm_g + layer * D + c), s = *(const f32x4*)(mod + D + c); gs[j] = g * (s + 1.0f); sh[j] = *(const f32x4*)(mod + c); }
        for (int rr = 0; rr < 8; ++rr) { const int row = rg * 8 + rr;
            const GAS f32x4* xr = (const GAS f32x4*)(xin + (size_t)row * D) + lane; f32x4 v[4]; float s = 0.f;
#pragma unroll
            for (int j = 0; j < 4; ++j) { v[j] = xr[64 * j]; s += (v[j].x * v[j].x + v[j].y * v[j].y) + (v[j].z * v[j].z + v[j].w * v[j].w); }
            const float rstd = 1.0f / sqrtf(wave_sum(s) * (1.0f / D) + NORM_EPS);
            GAS unsigned long long* o8 = (GAS unsigned long long*)((bf16_t*)(p.ws + WS_HY) + (size_t)row * D) + lane;
#pragma unroll
            for (int j = 0; j < 4; ++j) { const f32x4 o = v[j] * rstd * gs[j] + sh[j]; o8[64 * j] = (unsigned long long)pk2(o.x, o.y) | ((unsigned long long)pk2(o.z, o.w) << 32); }
        }
    }
}
__device__ __forceinline__ void final_phase(Frame& F, const Ptrs& p) {
    const int gw = F.vcu * NWAVES + F.wave, NGW = F.G * NWAVES, lane = F.lane;
    f32x4 g[4];
#pragma unroll
    for (int j = 0; j < 4; ++j) g[j] = *(const f32x4*)(p.final_g + 4 * lane + 256 * j);
    for (int row = gw; row < M; row += NGW) {
        GAS f32x4* xr = (GAS f32x4*)(p.out + (size_t)row * D) + lane; f32x4 v[4]; float s = 0.f;
#pragma unroll
        for (int j = 0; j < 4; ++j) { v[j] = xr[64 * j]; s += (v[j].x * v[j].x + v[j].y * v[j].y) + (v[j].z * v[j].z + v[j].w * v[j].w); }
        const float rstd = 1.0f / sqrtf(wave_sum(s) * (1.0f / D) + NORM_EPS);
#pragma unroll
        for (int j = 0; j < 4; ++j) xr[64 * j] = v[j] * rstd * g[j];
    }
}
namespace at {
typedef short bf16x8 __attribute__((ext_vector_type(8)));
typedef short s16x4 __attribute__((ext_vector_type(4)));
typedef short v4i16_t __attribute__((ext_vector_type(4)));
typedef float f32x16 __attribute__((ext_vector_type(16)));
typedef float f32x4 __attribute__((ext_vector_type(4)));
typedef float f32x2_t __attribute__((ext_vector_type(2)));
typedef __bf16 bf16x2_t __attribute__((ext_vector_type(2)));
typedef unsigned u32x4 __attribute__((ext_vector_type(4)));
typedef unsigned u32x2 __attribute__((ext_vector_type(2)));
typedef LAS const unsigned char* lcp;
typedef LAS unsigned char* lp;
#define MFMA32(a, b, c) __builtin_amdgcn_mfma_f32_32x32x16_bf16(a, b, c, 0, 0, 0)
constexpr float THR = 8.0f;
constexpr float SB_DONE = 150.0f;

__device__ __forceinline__ int crow(int r, int hi) { return (r & 3) + 8 * (r >> 2) + 4 * hi; }
__device__ __forceinline__ unsigned cvtpk(float lo, float hi) { f32x2_t v = {lo, hi}; bf16x2_t b = __builtin_convertvector(v, bf16x2_t); return __builtin_bit_cast(unsigned, b); }
__device__ __forceinline__ s16x4 vtr(lcp p) { return __builtin_bit_cast(s16x4, __builtin_amdgcn_ds_read_tr16_b64_v4i16((LAS v4i16_t*)p)); }
__device__ __forceinline__ float xmax(float m) { auto rr = __builtin_amdgcn_permlane32_swap(__float_as_uint(m), __float_as_uint(m), false, false); return fmaxf(__uint_as_float(rr[0]), __uint_as_float(rr[1])); }
__device__ __forceinline__ float xsum(float m) { auto rr = __builtin_amdgcn_permlane32_swap(__float_as_uint(m), __float_as_uint(m), false, false); return __uint_as_float(rr[0]) + __uint_as_float(rr[1]); }
__device__ __forceinline__ void xboth(float v, float& lo, float& hi) { auto rr = __builtin_amdgcn_permlane32_swap(__float_as_uint(v), __float_as_uint(v), false, false); lo = __uint_as_float(rr[0]); hi = __uint_as_float(rr[1]); }
__device__ __forceinline__ void dma16(const void* g, lp dst_uniform) { __builtin_amdgcn_global_load_lds((const unsigned*)g, (LAS unsigned*)dst_uniform, 16, 0, 0); }
#define AT_DRAIN_BAR() do { asm volatile("s_waitcnt vmcnt(0)" ::: "memory"); __syncthreads(); } while (0)

template <int ND0> __device__ __forceinline__ void qk_tile(f32x16& p0, f32x16& p1, lcp kslot, const bf16x8* qr, int r32, int hi) {
    const lcp kb = kslot + hi * 1024 + r32 * 16; const f32x16 z = {};
#pragma unroll
    for (int d0 = 0; d0 < ND0; ++d0) {
        const bf16x8 b0 = *(const LAS bf16x8*)(kb + d0 * 2048), b1 = *(const LAS bf16x8*)(kb + d0 * 2048 + 512);
        p0 = MFMA32(b0, qr[d0], d0 == 0 ? z : p0); p1 = MFMA32(b1, qr[d0], d0 == 0 ? z : p1); }
}
__device__ __forceinline__ void pack_p(const f32x16& p0, const f32x16& p1, u32x4 (&pw)[4]) {
    pw[0] = (u32x4){cvtpk(p0[0], p0[1]), cvtpk(p0[2], p0[3]), cvtpk(p0[4], p0[5]), cvtpk(p0[6], p0[7])};
    pw[1] = (u32x4){cvtpk(p0[8], p0[9]), cvtpk(p0[10], p0[11]), cvtpk(p0[12], p0[13]), cvtpk(p0[14], p0[15])};
    pw[2] = (u32x4){cvtpk(p1[0], p1[1]), cvtpk(p1[2], p1[3]), cvtpk(p1[4], p1[5]), cvtpk(p1[6], p1[7])};
    pw[3] = (u32x4){cvtpk(p1[8], p1[9]), cvtpk(p1[10], p1[11]), cvtpk(p1[12], p1[13]), cvtpk(p1[14], p1[15])};
}
template <int NDB> __device__ __forceinline__ void pv_tile(f32x16* o, lcp vslot, int lane, int hi, const u32x4 (&pw)[4]) {
    const lcp vb = vslot + ((lane >> 4) & 1) * 32 + (lane & 3) * 8 + (4 * hi + ((lane & 15) >> 2)) * 64;
#pragma unroll
    for (int db = 0; db < NDB; ++db)
#pragma unroll
        for (int ks = 0; ks < 4; ++ks) {
            const s16x4 lo = vtr(vb + db * 4096 + ks * 1024), hh = vtr(vb + db * 4096 + ks * 1024 + 512);
            const bf16x8 bfrag = {lo[0], lo[1], lo[2], lo[3], hh[0], hh[1], hh[2], hh[3]};
            o[db] = MFMA32(__builtin_bit_cast(bf16x8, pw[ks]), bfrag, o[db]); }
}
__device__ __forceinline__ float rowmax32(const f32x16& p0, const f32x16& p1) {
    float a = fmaxf(p0[0], p1[0]);
#pragma unroll
    for (int r = 1; r < 16; ++r) a = fmaxf(a, fmaxf(p0[r], p1[r]));
    return xmax(a);
}
template <int NDB> __device__ __forceinline__ void softmax_step(f32x16& p0, f32x16& p1, float& mhat, float& l, f32x16* o, bool first, LAS float* wsf, int r32, int hi) {
    const float rm = rowmax32(p0, p1);
    if (first) mhat = rm;
    else if (__any(rm > mhat + THR)) {
        const float mn = fmaxf(mhat, rm), f = __builtin_amdgcn_exp2f(mhat - mn); l *= f; mhat = mn;
        if (hi == 0) wsf[r32] = f;
#pragma unroll
        for (int r = 0; r < 16; ++r) { const float fr_ = wsf[crow(r, hi)];
#pragma unroll
            for (int db = 0; db < NDB; ++db) o[db][r] *= fr_; }
    }
    float s = 0.f;
#pragma unroll
    for (int r = 0; r < 16; ++r) { p0[r] = __builtin_amdgcn_exp2f(p0[r] - mhat); p1[r] = __builtin_amdgcn_exp2f(p1[r] - mhat); s += p0[r] + p1[r]; }
    l += s;
}
__device__ __forceinline__ void store_o64(const f32x16* o, const float* rs, LAS float* stg, const bf16_t* zg  , bf16_t* y, int lane, int r32, int hi) {
#pragma unroll
    for (int r = 0; r < 16; ++r) { const int orow = crow(r, hi); stg[orow * 64 + r32] = o[0][r] * rs[r]; stg[orow * 64 + 32 + r32] = o[1][r] * rs[r]; }
#pragma unroll
    for (int i = 0; i < 4; ++i) { const int row = i * 8 + (lane >> 3), ch = lane & 7;
        const f32x4 a = *(const LAS f32x4*)(stg + row * 64 + ch * 8), b = *(const LAS f32x4*)(stg + row * 64 + ch * 8 + 4);
        const u32x4 z = *(const u32x4*)(zg + (size_t)row * 1024 + ch * 8);
        u32x4 w; w.x = cvtpk(a[0] * bf2f(z.x & 0xffffu), a[1] * bf2f(z.x >> 16)); w.y = cvtpk(a[2] * bf2f(z.y & 0xffffu), a[3] * bf2f(z.y >> 16));
        w.z = cvtpk(b[0] * bf2f(z.z & 0xffffu), b[1] * bf2f(z.z >> 16)); w.w = cvtpk(b[2] * bf2f(z.w & 0xffffu), b[3] * bf2f(z.w >> 16));
        *(u32x4*)(y + (size_t)row * 1024 + ch * 8) = w; }
}

constexpr int A0_K = 0, A0_KSLOT = 12288, A0_V = 24576, A0_VSLOT = 8192, A0_WSF = 40960, A0_FLAG = 43008, A0_STG = 44032;
__device__ __forceinline__ void mla_unit(const Ptrs& p, lp lds, int b, int h, int qb) {
    const int tid = threadIdx.x, lane = tid & 63, r32 = lane & 31, hi = lane >> 5, wid = __builtin_amdgcn_readfirstlane(tid >> 6);
    const size_t rowbase = (size_t)b * SEQ; const int q0 = qb * 256;
    const bf16_t* Qw = (const bf16_t*)(p.ws + WS_QM) + (rowbase + q0 + wid * 32) * 768 + h * 96;
    const bf16_t* Kh = (const bf16_t*)(p.ws + WS_KM) + rowbase * 768 + h * 96;
    const bf16_t* Vh = (const bf16_t*)(p.ws + WS_VM) + rowbase * 512 + h * 64;
    const int NT = 4 * (qb + 1), mylast = 4 * qb + (wid >> 1);
    LAS float* wsf = (LAS float*)(lds + A0_WSF) + wid * 64;
    const bf16_t* ksrc = Kh + (size_t)lane * 768 + wid * 8;
    const bf16_t* vsrc = Vh + (size_t)(16 * (wid & 3) + (lane >> 2)) * 512 + (wid >> 2) * 32 + (lane & 3) * 8;
#define MLA_STAGE(t, s) do { dma16(ksrc + (size_t)(t) * 64 * 768, lds + A0_K + (s) * A0_KSLOT + wid * 1024); \
        if (wid < 4) dma16(ksrc + (size_t)(t) * 64 * 768 + 64, lds + A0_K + (s) * A0_KSLOT + (8 + wid) * 1024); \
        dma16(vsrc + (size_t)(t) * 64 * 512, lds + A0_V + (s) * A0_VSLOT + wid * 1024); } while (0)
    MLA_STAGE(0, 0);
    bf16x8 qr[6];
#pragma unroll
    for (int d0 = 0; d0 < 6; ++d0) qr[d0] = *(const bf16x8*)(Qw + (size_t)r32 * 768 + d0 * 16 + hi * 8);
    f32x16 o[2]; o[0] = f32x16{}; o[1] = f32x16{}; float mhat = 0.f, l = 0.f;
    for (int t = 0; t < NT; ++t) {
        AT_DRAIN_BAR();
        if (t + 1 < NT) MLA_STAGE(t + 1, (t + 1) & 1);
        if (t <= mylast) {
            f32x16 p0, p1; u32x4 pw[4];
            qk_tile<6>(p0, p1, (lcp)(lds + A0_K + (t & 1) * A0_KSLOT), qr, r32, hi);
            softmax_step<2>(p0, p1, mhat, l, o, t == 0, wsf, r32, hi);
            pack_p(p0, p1, pw);
            pv_tile<2>(o, (lcp)(lds + A0_V + (t & 1) * A0_VSLOT), lane, hi, pw);
        }
    }
#undef MLA_STAGE
    l = xsum(l);
    if (hi == 0) wsf[32 + r32] = l;
    float rs[16];
#pragma unroll
    for (int r = 0; r < 16; ++r) rs[r] = __builtin_amdgcn_rcpf(wsf[32 + crow(r, hi)]);
    const size_t orow0 = rowbase + q0 + wid * 32;
    store_o64(o, rs, (LAS float*)(lds + A0_STG) + wid * 2048, (const bf16_t*)(p.ws + WS_ZG0) + orow0 * 1024 + h * 64, (bf16_t*)(p.ws + WS_HY) + orow0 * 1024 + h * 64, lane, r32, hi);
    __syncthreads();
}
__device__ __forceinline__ void sb_unit(const Ptrs& p, lp lds, int b, int h, int qb) {
    const int tid = threadIdx.x, lane = tid & 63, r32 = lane & 31, hi = lane >> 5, wid = __builtin_amdgcn_readfirstlane(tid >> 6);
    const size_t rowbase = (size_t)b * SEQ; const int q0 = qb * 256;
    const bf16_t* Qw = (const bf16_t*)(p.ws + WS_QSB) + (rowbase + q0 + wid * 32) * 512 + h * 64;
    const bf16_t* Kh = (const bf16_t*)(p.ws + WS_KSB) + rowbase * 512 + h * 64;
    const bf16_t* Vh = (const bf16_t*)(p.ws + WS_VSB) + rowbase * 512 + h * 64;
    const int NT = 4 * (qb + 1), td = 4 * qb + (wid >> 1), qrel = 32 * (wid & 1) + r32;
    LAS unsigned* flag = (LAS unsigned*)(lds + A0_FLAG);
    const bf16_t* ksrc = Kh + (size_t)lane * 512 + wid * 8;
    const bf16_t* vsrc = Vh + (size_t)(16 * (wid & 3) + (lane >> 2)) * 512 + (wid >> 2) * 32 + (lane & 3) * 8;
#define SB_STAGE(t, s) do { dma16(ksrc + (size_t)(t) * 64 * 512, lds + A0_K + (s) * A0_KSLOT + wid * 1024); dma16(vsrc + (size_t)(t) * 64 * 512, lds + A0_V + (s) * A0_VSLOT + wid * 1024); } while (0)
    SB_STAGE(NT - 1, 0);
    if (lane == 0) { flag[wid] = 0u; flag[8 + wid] = 0u; }
    bf16x8 qr[4];
#pragma unroll
    for (int d0 = 0; d0 < 4; ++d0) qr[d0] = *(const bf16x8*)(Qw + (size_t)r32 * 512 + d0 * 16 + hi * 8);
    f32x16 o[2]; o[0] = f32x16{}; o[1] = f32x16{}; float carry = 0.f; bool mydone = false;
    for (int it = 0, t = NT - 1; t >= 0; ++it, --t) {
        AT_DRAIN_BAR();
        { const LAS unsigned* fl = flag + ((it + 1) & 1) * 8; unsigned all = 1u;
#pragma unroll
          for (int w = 0; w < 8; ++w) all &= fl[w];
          if (it > 0 && all) break; }
        if (t > 0) SB_STAGE(t - 1, (it + 1) & 1);
        if (t <= td && !mydone) {
            f32x16 z0, z1; u32x4 pw[4];
            qk_tile<4>(z0, z1, (lcp)(lds + A0_K + (it & 1) * A0_KSLOT), qr, r32, hi);
            f32x16 s0, s1; float G[8];
            const bool diag = (t == td);
#pragma unroll
            for (int r = 0; r < 16; ++r) {
                float a = fmaxf(z0[r], 0.f) + __builtin_amdgcn_logf(1.0f + __builtin_amdgcn_exp2f(-fabsf(z0[r])));
                float c = fmaxf(z1[r], 0.f) + __builtin_amdgcn_logf(1.0f + __builtin_amdgcn_exp2f(-fabsf(z1[r])));
                if (diag) { if (crow(r, hi) >= qrel) a = 0.f; if (32 + crow(r, hi) >= qrel) c = 0.f; }
                s0[r] = a; s1[r] = c; }
#pragma unroll
            for (int g = 0; g < 4; ++g) { G[g] = (s0[4 * g] + s0[4 * g + 1]) + (s0[4 * g + 2] + s0[4 * g + 3]); G[4 + g] = (s1[4 * g] + s1[4 * g + 1]) + (s1[4 * g + 2] + s1[4 * g + 3]); }
            float Gh[8], T[8];
#pragma unroll
            for (int m = 0; m < 8; ++m) { float lo_, hi_; xboth(G[m], lo_, hi_); Gh[m] = hi_; T[m] = lo_ + hi_; }
            float E[8]; float run = 0.f;
#pragma unroll
            for (int m = 7; m >= 0; --m) { E[m] = carry + run + (hi == 0 ? Gh[m] : 0.f); run += T[m]; }
            carry += run;
#pragma unroll
            for (int g = 0; g < 4; ++g) {
                float a3 = E[g] + s0[4 * g + 3], a2 = a3 + s0[4 * g + 2], a1 = a2 + s0[4 * g + 1], a0 = a1 + s0[4 * g];
                z0[4 * g] = __builtin_amdgcn_exp2f(z0[4 * g] - a0); z0[4 * g + 1] = __builtin_amdgcn_exp2f(z0[4 * g + 1] - a1); z0[4 * g + 2] = __builtin_amdgcn_exp2f(z0[4 * g + 2] - a2); z0[4 * g + 3] = __builtin_amdgcn_exp2f(z0[4 * g + 3] - a3);
                float b3 = E[4 + g] + s1[4 * g + 3], b2 = b3 + s1[4 * g + 2], b1 = b2 + s1[4 * g + 1], b0 = b1 + s1[4 * g];
                z1[4 * g] = __builtin_amdgcn_exp2f(z1[4 * g] - b0); z1[4 * g + 1] = __builtin_amdgcn_exp2f(z1[4 * g + 1] - b1); z1[4 * g + 2] = __builtin_amdgcn_exp2f(z1[4 * g + 2] - b2); z1[4 * g + 3] = __builtin_amdgcn_exp2f(z1[4 * g + 3] - b3); }
            if (diag) {
#pragma unroll
                for (int r = 0; r < 16; ++r) { if (crow(r, hi) >= qrel) z0[r] = 0.f; if (32 + crow(r, hi) >= qrel) z1[r] = 0.f; } }
            pack_p(z0, z1, pw);
            pv_tile<2>(o, (lcp)(lds + A0_V + (it & 1) * A0_VSLOT), lane, hi, pw);
            mydone = __all(carry > SB_DONE);
        }
        if (lane == 0) flag[(it & 1) * 8 + wid] = mydone ? 1u : 0u;
    }
#undef SB_STAGE
    asm volatile("s_waitcnt vmcnt(0)" ::: "memory");
    float rs[16];
#pragma unroll
    for (int r = 0; r < 16; ++r) rs[r] = 1.0f;
    const size_t orow0 = rowbase + q0 + wid * 32;
    store_o64(o, rs, (LAS float*)(lds + A0_STG) + wid * 2048, (const bf16_t*)(p.ws + WS_ZG0) + orow0 * 1024 + 512 + h * 64, (bf16_t*)(p.ws + WS_HY) + orow0 * 1024 + 512 + h * 64, lane, r32, hi);
    __syncthreads();
}

constexpr int A1_K = 0, A1_KSLOT = 16384, A1_V = 32768, A1_VSLOT = 16384, A1_X = 65536, A1_WSF = 132096, A1_LUT = 134144;
__device__ __forceinline__ void diff_unit(const Ptrs& p, lp lds, int b, int h, int qb) {
    const int tid = threadIdx.x, lane = tid & 63, r32 = lane & 31, hi = lane >> 5, wid = __builtin_amdgcn_readfirstlane(tid >> 6), rg = wid & 3, cc = wid >> 2;
    const size_t rowbase = (size_t)b * SEQ; const int q0 = qb * 128, qlo = q0 + rg * 32;
    const bf16_t* Qw = (const bf16_t*)(p.ws + WS_Q1) + (rowbase + qlo) * 1024 + h * 128 + cc * 64;
    const bf16_t* Kh = (const bf16_t*)(p.ws + WS_K1) + rowbase * 1024 + h * 128;
    const bf16_t* Vh = (const bf16_t*)(p.ws + WS_V1) + rowbase * 1024 + h * 128;
    const int NT = 2 * (qb + 1), mylast = 2 * qb + (rg >> 1);
    LAS float* wsf = (LAS float*)(lds + A1_WSF) + wid * 64;
    LAS float* lut = (LAS float*)(lds + A1_LUT);
    const bf16_t* ksrc = Kh + (size_t)lane * 1024 + wid * 8;
    const bf16_t* vsrc = Vh + (size_t)(16 * (wid & 3) + (lane >> 2)) * 1024 + (wid >> 2) * 32 + (lane & 3) * 8;
#define DF_STAGE(t, s) do { dma16(ksrc + (size_t)(t) * 64 * 1024, lds + A1_K + (s) * A1_KSLOT + wid * 1024); dma16(ksrc + (size_t)(t) * 64 * 1024 + 64, lds + A1_K + (s) * A1_KSLOT + (8 + wid) * 1024); \
        dma16(vsrc + (size_t)(t) * 64 * 1024, lds + A1_V + (s) * A1_VSLOT + wid * 1024); dma16(vsrc + (size_t)(t) * 64 * 1024 + 64, lds + A1_V + (s) * A1_VSLOT + (8 + wid) * 1024); } while (0)
    DF_STAGE(0, 0);
    if (tid < 249) lut[tid] = p.rel_table[t5_bucket(tid - 185) * 8 + h] * LOG2E;
    const float bfar = p.rel_table[15 * 8 + h] * LOG2E;
    float lam; { float d1 = p.lq1[lane] * p.lk1[lane], d2 = p.lq2[lane] * p.lk2[lane]; d1 = wave_sum(d1); d2 = wave_sum(d2); lam = __expf(d1) - __expf(d2) + LAM_INIT; }
    bf16x8 qr[4];
#pragma unroll
    for (int d0 = 0; d0 < 4; ++d0) qr[d0] = *(const bf16x8*)(Qw + (size_t)r32 * 1024 + d0 * 16 + hi * 8);
    f32x16 o[4]; o[0] = f32x16{}; o[1] = f32x16{}; o[2] = f32x16{}; o[3] = f32x16{}; float mhat = 0.f, l = 0.f;
    for (int t = 0; t < NT; ++t) {
        AT_DRAIN_BAR();
        if (t + 1 < NT) DF_STAGE(t + 1, (t + 1) & 1);
        if (t <= mylast) {
            f32x16 p0, p1; u32x4 pw[4];
            qk_tile<4>(p0, p1, (lcp)(lds + A1_K + (t & 1) * A1_KSLOT + cc * 8192), qr, r32, hi);
            if (64 * t + 63 - qlo <= -91) {
#pragma unroll
                for (int r = 0; r < 16; ++r) { p0[r] += bfar; p1[r] += bfar; }
            } else {
                const LAS float* lb = lut + (64 * t - qlo + 185 - r32 + 4 * hi);
#pragma unroll
                for (int r = 0; r < 16; ++r) { p0[r] += lb[8 * (r >> 2) + (r & 3)]; p1[r] += lb[32 + 8 * (r >> 2) + (r & 3)]; }
            }
            softmax_step<4>(p0, p1, mhat, l, o, t == 0, wsf, r32, hi);
            pack_p(p0, p1, pw);
            pv_tile<4>(o, (lcp)(lds + A1_V + (t & 1) * A1_VSLOT), lane, hi, pw);
        }
    }
#undef DF_STAGE
    l = xsum(l);
    if (hi == 0) wsf[32 + r32] = l;
    LAS float* X = (LAS float*)(lds + A1_X) + rg * 4096;
    const float fac = cc ? lam : 1.0f;
    if (cc == 1) {
#pragma unroll
        for (int r = 0; r < 16; ++r) { const float rs = fac * __builtin_amdgcn_rcpf(wsf[32 + crow(r, hi)]); const int orow = crow(r, hi);
#pragma unroll
            for (int db = 0; db < 4; ++db) X[orow * 128 + db * 32 + r32] = o[db][r] * rs; }
    }
    __syncthreads();
    if (cc == 0) {
#pragma unroll
        for (int r = 0; r < 16; ++r) { const float rs = __builtin_amdgcn_rcpf(wsf[32 + crow(r, hi)]); const int orow = crow(r, hi);
#pragma unroll
            for (int db = 0; db < 4; ++db) { LAS float* xp = X + orow * 128 + db * 32 + r32; *xp = o[db][r] * rs - *xp; } }
        const int c4 = 4 * r32; const f32x4 g4 = *(const f32x4*)(p.subln_g + c4);
        const size_t yrow0 = rowbase + qlo;
#pragma unroll 4
        for (int i2 = 0; i2 < 16; ++i2) { const int row = 2 * i2 + hi; const f32x4 v = *(const LAS f32x4*)(X + row * 128 + c4);
            float ss = (v[0] * v[0] + v[1] * v[1]) + (v[2] * v[2] + v[3] * v[3]);
            ss += __shfl_xor(ss, 1); ss += __shfl_xor(ss, 2); ss += __shfl_xor(ss, 4); ss += __shfl_xor(ss, 8); ss += __shfl_xor(ss, 16);
            const float rstd = (1.0f - LAM_INIT) / sqrtf(ss * (1.0f / 128.0f) + SUBLN_EPS);
            const u32x2 z = *(const u32x2*)((const bf16_t*)(p.ws + WS_ZG1) + (yrow0 + row) * 1024 + h * 128 + c4);
            u32x2 w; w.x = cvtpk(v[0] * rstd * g4[0] * bf2f(z.x & 0xffffu), v[1] * rstd * g4[1] * bf2f(z.x >> 16)); w.y = cvtpk(v[2] * rstd * g4[2] * bf2f(z.y & 0xffffu), v[3] * rstd * g4[3] * bf2f(z.y >> 16));
            *(u32x2*)((bf16_t*)(p.ws + WS_HY) + (yrow0 + row) * 1024 + h * 128 + c4) = w; }
    }
    __syncthreads();
}
}

__device__ __forceinline__ void attn0_phase(Frame& F, const Ptrs& p) {
    for (int pi = F.vcu; pi < 256; pi += F.G) { const int bh = pi >> 2, s = pi & 3, b = bh >> 3, h = bh & 7;
        at::mla_unit(p, F.lds, b, h, 7 - s); at::mla_unit(p, F.lds, b, h, s);
        at::sb_unit(p, F.lds, b, h, 7 - s); at::sb_unit(p, F.lds, b, h, s); }
}

__device__ __forceinline__ void attn1_phase(Frame& F, const Ptrs& p) {
    for (int pi = F.vcu; pi < 256; pi += F.G) { const int bh = pi >> 2, s = pi & 3, b = bh >> 3, h = bh & 7;
        at::diff_unit(p, F.lds, b, h, 15 - s); at::diff_unit(p, F.lds, b, h, s); at::diff_unit(p, F.lds, b, h, 11 - s); at::diff_unit(p, F.lds, b, h, 4 + s); }
}
#ifndef FAST_MASK
#define FAST_MASK 0x7FF
#endif
constexpr int N_PHASES = 11;
struct Args { Ptrs p; int ph_lo, ph_hi, li, pad; };
__global__ void __launch_bounds__(NWAVES * 64, 2) mega(Args args) {
    extern __shared__ __attribute__((aligned(16))) unsigned char lds[];
    const Ptrs& p = args.p;
    Frame F;
    F.lds = (LAS unsigned char*)lds; F.MISC = (volatile LAS unsigned*)(F.lds + MISC_OFF);
    F.tid = threadIdx.x; F.lane = F.tid & 63; F.wave = __builtin_amdgcn_readfirstlane(F.tid >> 6);
    F.G = gridDim.x; { const int bx = blockIdx.x; F.vcu = (F.G % 8 == 0) ? (bx % 8) * (F.G / 8) + bx / 8 : bx; }
    F.ctl = (gu32*)(p.ws + WS_CTL);
    for (int u = F.tid; u < (LDS_BYTES - LDSCTL_OFF) / 4; u += NWAVES * 64) ((LAS unsigned*)(F.lds + LDSCTL_OFF))[u] = 0u;
    __syncthreads();
    XcdBarrier bar = xcd_barrier_post((unsigned*)(F.ctl + CW_BAR) + args.li * XCD_BAR_WORDS, F.MISC + 8);
    const int lo = args.ph_lo, hi = args.ph_hi;
#define IN(k) (lo <= (k) && (k) < hi)
#define SEAM(k) do { if (IN(k) && IN((k) + 1)) xcd_barrier(bar); } while (0)
    unsigned char* ws = p.ws;
    const float* MODG = (const float*)(ws + WS_MOD) + 2 * D;

    if (IN(0)) { p0_prologue(F, p); SEAM(0); }
    if (IN(1)) { normmod_phase(F, p, p.x, 0); SEAM(1); }
    if (IN(2)) {
        pg8::Gemm g{(const bf16_t*)(ws + WS_HY), (const bf16_t*)(ws + WS_W0T), M, N0P, D, D}; pg8::StaticOrder S; S.init(M, N0P, F.G, (int)blockIdx.x);
        pg8::EpiG1 E{ws}; pg8::gemm_phase<pg8::EpiG1, pg8::StaticOrder, true, true>(F.lds + RING_OFF, g, S, E); SEAM(2); }
    if (IN(3)) {
        { pg8::Gemm g{(const bf16_t*)(ws + WS_CKV), (const bf16_t*)(ws + WS_WUKVT), M, 1024, 256, 256}; pg8::StaticOrder S; S.init(M, 1024, F.G, (int)blockIdx.x);
          pg8::EpiUKV E{ws}; pg8::gemm_phase<pg8::EpiUKV, pg8::StaticOrder, true, true>(F.lds + RING_OFF, g, S, E); }
        { pg8::Gemm g{(const bf16_t*)(ws + WS_CQ), (const bf16_t*)(ws + WS_WUQT), M, 768, 384, 384}; pg8::StaticOrder S; S.init(M, 768, F.G, (int)blockIdx.x);
          pg8::EpiUQ E{ws}; pg8::gemm_phase<pg8::EpiUQ, pg8::StaticOrder, true, true>(F.lds + RING_OFF, g, S, E); }
        SEAM(3); }
    if (IN(4)) { attn0_phase(F, p); SEAM(4); }
    if (IN(5)) {
        pg8::Gemm g{(const bf16_t*)(ws + WS_HY), (const bf16_t*)(ws + WS_WO0T), M, D, D, D}; pg8::StaticOrder S; S.init(M, D, F.G, (int)blockIdx.x);
        pg8::EpiOut E{p.x, p.out, MODG}; pg8::gemm_phase<pg8::EpiOut, pg8::StaticOrder, true, true>(F.lds + RING_OFF, g, S, E); SEAM(5); }
    if (IN(6)) { normmod_phase(F, p, p.out, 1); SEAM(6); }
    if (IN(7)) {
        pg8::Gemm g{(const bf16_t*)(ws + WS_HY), (const bf16_t*)(ws + WS_W1T), M, DIFF_IN, D, D}; pg8::StaticOrder S; S.init(M, DIFF_IN, F.G, (int)blockIdx.x);
        pg8::EpiG4 E{ws}; pg8::gemm_phase<pg8::EpiG4, pg8::StaticOrder, true, true>(F.lds + RING_OFF, g, S, E); SEAM(7); }
    if (IN(8)) { attn1_phase(F, p); SEAM(8); }
    if (IN(9)) {
        pg8::Gemm g{(const bf16_t*)(ws + WS_HY), (const bf16_t*)(ws + WS_WO1T), M, D, D, D}; pg8::StaticOrder S; S.init(M, D, F.G, (int)blockIdx.x);
        pg8::EpiOut E{p.out, p.out, MODG + (size_t)BATCH * MOD_W}; pg8::gemm_phase<pg8::EpiOut, pg8::StaticOrder, true, true>(F.lds + RING_OFF, g, S, E); SEAM(9); }
    if (IN(10)) { final_phase(F, p); }
#undef IN
#undef SEAM
}

extern "C" void kernel_launch(void* const* d_in, const int* in_sizes, int n_in, void* d_out, int out_size, void* d_ws, size_t ws_size, hipStream_t stream) {
    static int grid = 0;
    if (grid == 0) {
        if (n_in != 21 || out_size != M * D || ws_size < WS_END) { fprintf(stderr, "kernel_launch: unexpected shapes (n_in %d out %d ws %zu)\n", n_in, out_size, ws_size); grid = -1; return; }
        int dev = 0, cus = 0, per_cu = 0;
        if (hipGetDevice(&dev) != hipSuccess || hipDeviceGetAttribute(&cus, hipDeviceAttributeMultiprocessorCount, dev) != hipSuccess) { grid = -1; return; }
        if (hipFuncSetAttribute((const void*)mega, hipFuncAttributeMaxDynamicSharedMemorySize, LDS_BYTES) != hipSuccess) { fprintf(stderr, "kernel_launch: hipFuncSetAttribute failed\n"); grid = -1; return; }
        if (hipOccupancyMaxActiveBlocksPerMultiprocessor(&per_cu, (const void*)mega, NWAVES * 64, LDS_BYTES) != hipSuccess || per_cu < 1) { fprintf(stderr, "kernel_launch: occupancy query says %d blocks/CU\n", per_cu); (void)hipGetLastError(); grid = -1; return; }
        (void)hipGetLastError();
        grid = cus;
    }
    if (grid < 0) return;
    Ptrs p{};
    p.x = (const float*)d_in[0]; p.c = (const float*)d_in[1]; p.pos_offset = (const int*)d_in[2]; p.rel_table = (const float*)d_in[3]; p.ada_w = (const float*)d_in[4]; p.ada_b = (const float*)d_in[5];
    p.norm_g = (const float*)d_in[6]; p.final_g = (const float*)d_in[7]; p.ab_w_in = (const float*)d_in[8]; p.ab_q_norm_g = (const float*)d_in[9]; p.ab_kv_norm_g = (const float*)d_in[10];
    p.ab_w_uq = (const float*)d_in[11]; p.ab_w_ukv = (const float*)d_in[12]; p.ab_w_out = (const float*)d_in[13]; p.dif_w_in = (const float*)d_in[14];
    p.lq1 = (const float*)d_in[15]; p.lk1 = (const float*)d_in[16]; p.lq2 = (const float*)d_in[17]; p.lk2 = (const float*)d_in[18]; p.subln_g = (const float*)d_in[19]; p.dif_w_out = (const float*)d_in[20];
    p.out = (float*)d_out; p.ws = (unsigned char*)d_ws;
    (void)hipMemsetAsync((char*)d_ws + WS_CTL, 0, CTL_ZERO_BYTES, stream);
    int li = 0;
    for (int ph = 0; ph < N_PHASES;) {
        if ((FAST_MASK >> ph) & 1) {
            int e = ph; while (e < N_PHASES && ((FAST_MASK >> e) & 1)) ++e;
            Args a{}; a.p = p; a.ph_lo = ph; a.ph_hi = e; a.li = li++;
            hipLaunchKernelGGL(mega, dim3(grid), dim3(NWAVES * 64), LDS_BYTES, stream, a);
            ph = e;
        } else {
            nv::run_phase(ph, p, stream);
            if (ph == 2) nv::k_ssqp<<<M / 256, 256, 0, stream>>>(p);
            ++ph;
        }
    }
}
```

```cpp
#include <hip/hip_runtime.h>
#include <cstdio>
#include <cstdint>
#include <cmath>

typedef unsigned short bf16_t;
#define GAS __attribute__((address_space(1)))
#define LAS __attribute__((address_space(3)))

constexpr int D = 1024, BATCH = 8, SEQ = 2048, M = BATCH * SEQ;
constexpr int MOD_W = 3 * D;
constexpr int AB_IN = 3232, N0P = 3328;
constexpr int DIFF_IN = 4096;
constexpr float LOG2E = 1.4426950408889634f;
constexpr float C_SB = 0.125f * LOG2E;
constexpr float C_MLA = 0.10206207261596577f * LOG2E;
constexpr float LAM_INIT = 0.35550906759096927f;
constexpr float NORM_EPS = 1e-6f, SUBLN_EPS = 1e-5f;

constexpr size_t MiB = 1u << 20;
constexpr size_t WS_CTL = 0, CTL_ZERO_BYTES = 1 * MiB;
constexpr size_t WS_MOD = 512 * 1024;
constexpr size_t WS_W0T = 1 * MiB;
constexpr size_t WS_WUQT = 8 * MiB;
constexpr size_t WS_WUKVT = 9 * MiB;
constexpr size_t WS_WO0T = 10 * MiB;
constexpr size_t WS_W1T = 12 * MiB;
constexpr size_t WS_WO1T = 20 * MiB;
constexpr size_t WS_RT = 22 * MiB;
constexpr size_t WS_HY = 24 * MiB;
constexpr size_t WS_CQ = 56 * MiB;
constexpr size_t WS_CKV = 68 * MiB;
constexpr size_t WS_QSB = 76 * MiB, WS_KSB = 92 * MiB, WS_VSB = 108 * MiB;
constexpr size_t WS_ZG0 = 124 * MiB;
constexpr size_t WS_QM = 156 * MiB, WS_KM = 180 * MiB;
constexpr size_t WS_VM = 204 * MiB;
constexpr size_t WS_RSTD = 220 * MiB;
constexpr size_t WS_Q1 = 56 * MiB, WS_K1 = 88 * MiB, WS_V1 = 120 * MiB, WS_ZG1 = 152 * MiB;
constexpr size_t WS_SSQ = 221 * MiB;
constexpr size_t WS_END = 224 * MiB;

__device__ __forceinline__ unsigned f2bf(float f) { unsigned u = __builtin_bit_cast(unsigned, f); return (u + 0x7fffu + ((u >> 16) & 1u)) >> 16; }
__device__ __forceinline__ float bf2f(unsigned h) { return __builtin_bit_cast(float, h << 16); }
__device__ __forceinline__ unsigned pk2(float lo, float hi) { return f2bf(lo) | (f2bf(hi) << 16); }
__device__ __forceinline__ float silu_f(float v) { return v / (1.0f + __expf(-v)); }
__host__ __device__ __forceinline__ int ropeidx(int p) { const int g = p >> 3, e = p & 7; return e < 4 ? 4 * g + e : 16 + 4 * g + (e - 4); }
__host__ __device__ __forceinline__ int ropeslot(int i) { return 8 * (i >> 2) + (i & 3); }
__host__ __device__ __forceinline__ int t5_bucket(int rel) {
    const int n = rel < 0 ? -rel : rel; int v;
    if (n < 8) v = n; else if (n < 12) v = 8; else if (n < 16) v = 9; else if (n < 23) v = 10; else if (n < 32) v = 11; else if (n < 46) v = 12; else if (n < 64) v = 13; else if (n < 91) v = 14; else v = 15;
    return (rel > 0 ? 16 : 0) + v;
}
__host__ __device__ __forceinline__ int w0_src(int n) {
    if (n < 640) return n;
    if (n < 672) return 640 + ropeidx(n - 640);
    if (n < 768) return -1;
    return n - 96;
}
__host__ __device__ __forceinline__ int wuq_src(int n) { const int h = n / 96, j = n % 96; return j < 64 ? n : 96 * h + 64 + ropeidx(j - 64); }

__host__ __device__ __forceinline__ size_t kimg_off(int nchunk, int b, int h, int t, int d) { return ((size_t)((b * 8 + h) * 32 + (t >> 6)) * nchunk + (d >> 3)) * 512 + (t & 63) * 8 + (d & 7); }
__host__ __device__ __forceinline__ size_t vimg_off(int ndb, int b, int h, int t, int d) { return ((size_t)((b * 8 + h) * 32 + (t >> 6)) * ndb * 4 + (d >> 5) * 4 + ((t & 63) >> 4)) * 512 + (t & 15) * 32 + (d & 31); }

struct Ptrs {
    const float* x; const float* c; const int* pos_offset; const float* rel_table; const float* ada_w; const float* ada_b; const float* norm_g; const float* final_g;
    const float* ab_w_in; const float* ab_q_norm_g; const float* ab_kv_norm_g; const float* ab_w_uq; const float* ab_w_ukv; const float* ab_w_out;
    const float* dif_w_in; const float* lq1; const float* lk1; const float* lq2; const float* lk2; const float* subln_g; const float* dif_w_out;
    float* out; unsigned char* ws;
};
namespace nv {

__global__ void k_mod(Ptrs p) {
    const int idx = blockIdx.x * blockDim.x + threadIdx.x;
    if (idx >= 2 * BATCH * MOD_W) return;
    const int n = idx % MOD_W, b = (idx / MOD_W) % BATCH, i = idx / (MOD_W * BATCH);
    const float* w = p.ada_w + (size_t)i * D * MOD_W + n; const float* cb = p.c + (size_t)b * D;
    float acc = 0.f;
    for (int k = 0; k < D; ++k) acc += silu_f(cb[k]) * w[(size_t)k * MOD_W];
    ((float*)(p.ws + WS_MOD))[idx] = acc + p.ada_b[i * MOD_W + n];
}
__global__ void k_wt(Ptrs p) {
    const size_t gid = (size_t)blockIdx.x * blockDim.x + threadIdx.x;
    const size_t n0 = (size_t)N0P * D, n1 = (size_t)768 * 384, n2 = (size_t)1024 * 256, n3 = (size_t)D * D, n4 = (size_t)DIFF_IN * D, n5 = (size_t)D * D;
    size_t r = gid;
    if (r < n0) { const int n = (int)(r / D), k = (int)(r % D); const int s = w0_src(n); ((bf16_t*)(p.ws + WS_W0T))[r] = (bf16_t)(s < 0 ? 0u : f2bf(p.ab_w_in[(size_t)k * AB_IN + s])); return; } r -= n0;
    if (r < n1) { const int n = (int)(r / 384), k = (int)(r % 384); ((bf16_t*)(p.ws + WS_WUQT))[r] = (bf16_t)f2bf(p.ab_q_norm_g[k] * p.ab_w_uq[(size_t)k * 768 + wuq_src(n)]); return; } r -= n1;
    if (r < n2) { const int n = (int)(r / 256), k = (int)(r % 256); ((bf16_t*)(p.ws + WS_WUKVT))[r] = (bf16_t)f2bf(p.ab_kv_norm_g[k] * p.ab_w_ukv[(size_t)k * 1024 + n]); return; } r -= n2;
    if (r < n3) { const int n = (int)(r / D), k = (int)(r % D); ((bf16_t*)(p.ws + WS_WO0T))[r] = (bf16_t)f2bf(p.ab_w_out[(size_t)k * D + n]); return; } r -= n3;
    if (r < n4) { const int n = (int)(r / D), k = (int)(r % D); ((bf16_t*)(p.ws + WS_W1T))[r] = (bf16_t)f2bf(p.dif_w_in[(size_t)k * DIFF_IN + n]); return; } r -= n4;
    if (r < n5) { const int n = (int)(r / D), k = (int)(r % D); ((bf16_t*)(p.ws + WS_WO1T))[r] = (bf16_t)f2bf(p.dif_w_out[(size_t)k * D + n]); return; }
}
__global__ void k_rt(Ptrs p) {
    const int idx = blockIdx.x * blockDim.x + threadIdx.x; if (idx >= M * 16) return;
    const int row = idx >> 4, i = idx & 15, b = row / SEQ, t = row % SEQ;
    const float pos = (float)(p.pos_offset[b] + t), inv = powf(10000.0f, -(float)i / 16.0f), ang = pos * inv;
    float s, c; sincosf(ang, &s, &c);
    ((float2*)(p.ws + WS_RT))[idx] = make_float2(c, s);
}
__global__ void k_normmod(Ptrs p, const float* xin, int layer) {
    __shared__ float red[256];
    const int row = blockIdx.x, b = row / SEQ, tid = threadIdx.x;
    const float* xr = xin + (size_t)row * D; float v[4], s = 0.f;
    for (int j = 0; j < 4; ++j) { v[j] = xr[tid + 256 * j]; s += v[j] * v[j]; }
    red[tid] = s; __syncthreads();
    for (int o = 128; o > 0; o >>= 1) { if (tid < o) red[tid] += red[tid + o]; __syncthreads(); }
    const float rstd = 1.0f / sqrtf(red[0] / D + NORM_EPS);
    const float* mod = (const float*)(p.ws + WS_MOD) + (size_t)(layer * BATCH + b) * MOD_W;
    bf16_t* h = (bf16_t*)(p.ws + WS_HY) + (size_t)row * D;
    for (int j = 0; j < 4; ++j) { const int n = tid + 256 * j; h[n] = (bf16_t)f2bf(v[j] * rstd * p.norm_g[layer * D + n] * (1.0f + mod[D + n]) + mod[n]); }
}
template <class Epi> __global__ void __launch_bounds__(256) k_gemm(const bf16_t* A, int lda, const bf16_t* Bt, int Mrows, int N, int K, Epi E) {
    __shared__ __attribute__((aligned(16))) float As[16][68], Bs[16][68];
    const int tid = threadIdx.x, tx = tid & 15, ty = tid >> 4, m0 = blockIdx.y * 64, n0 = blockIdx.x * 64;
    float acc[4][4]; for (int i = 0; i < 4; ++i) for (int j = 0; j < 4; ++j) acc[i][j] = 0.f;
    const int lr = tid >> 2, lk = (tid & 3) * 4;
    for (int k0 = 0; k0 < K; k0 += 16) {
        for (int e = 0; e < 4; ++e) { As[lk + e][lr] = bf2f(A[(size_t)(m0 + lr) * lda + k0 + lk + e]); Bs[lk + e][lr] = bf2f(Bt[(size_t)(n0 + lr) * K + k0 + lk + e]); }
        __syncthreads();
#pragma unroll
        for (int k = 0; k < 16; ++k) { float a[4], b[4];
#pragma unroll
            for (int i = 0; i < 4; ++i) { a[i] = As[k][ty * 4 + i]; b[i] = Bs[k][tx * 4 + i]; }
#pragma unroll
            for (int i = 0; i < 4; ++i)
#pragma unroll
                for (int j = 0; j < 4; ++j) acc[i][j] += a[i] * b[j]; }
        __syncthreads();
    }
#pragma unroll
    for (int i = 0; i < 4; ++i)
#pragma unroll
        for (int j = 0; j < 4; ++j) E(m0 + ty * 4 + i, n0 + tx * 4 + j, acc[i][j]);
}
struct EG1 { unsigned char* ws;
    __device__ void operator()(int row, int col, float v) const {
        if (col < 384) ((bf16_t*)(ws + WS_CQ))[(size_t)row * 384 + col] = (bf16_t)f2bf(v);
        else if (col < 640) ((bf16_t*)(ws + WS_CKV))[(size_t)row * 256 + col - 384] = (bf16_t)f2bf(v);
        else if (col < 768) return;
        else if (col < 1280) ((bf16_t*)(ws + WS_QSB))[(size_t)row * 512 + col - 768] = (bf16_t)f2bf(v * C_SB);
        else if (col < 1792) ((bf16_t*)(ws + WS_KSB))[(size_t)row * 512 + col - 1280] = (bf16_t)f2bf(v);
        else if (col < 2304) ((bf16_t*)(ws + WS_VSB))[(size_t)row * 512 + col - 1792] = (bf16_t)f2bf(v);
        else ((bf16_t*)(ws + WS_ZG0))[(size_t)row * 1024 + col - 2304] = (bf16_t)f2bf(silu_f(v)); } };
struct EG2a { unsigned char* ws;
    __device__ void operator()(int row, int col, float v) const { if (col % 96 >= 64) return;
        ((bf16_t*)(ws + WS_QM))[(size_t)row * 768 + col] = (bf16_t)f2bf(v * ((const float*)(ws + WS_RSTD))[row] * C_MLA); } };
struct EG2b { unsigned char* ws;
    __device__ void operator()(int row, int col, float v) const { const int h = col >> 7, j = col & 127; const float o = v * ((const float*)(ws + WS_RSTD))[M + row];
        if (j < 64) ((bf16_t*)(ws + WS_KM))[(size_t)row * 768 + 96 * h + j] = (bf16_t)f2bf(o); else ((bf16_t*)(ws + WS_VM))[(size_t)row * 512 + 64 * h + j - 64] = (bf16_t)f2bf(o); } };
struct EG3 { unsigned char* ws; const float* xin; float* xout; int layer;
    __device__ void operator()(int row, int col, float v) const { const int b = row / SEQ; const float g = ((const float*)(ws + WS_MOD))[(size_t)(layer * BATCH + b) * MOD_W + 2 * D + col];
        xout[(size_t)row * D + col] = xin[(size_t)row * D + col] + g * v; } };
struct EG4 { unsigned char* ws;
    __device__ void operator()(int row, int col, float v) const {
        if (col < 1024) ((bf16_t*)(ws + WS_Q1))[(size_t)row * 1024 + col] = (bf16_t)f2bf(v * C_SB);
        else if (col < 2048) ((bf16_t*)(ws + WS_K1))[(size_t)row * 1024 + col - 1024] = (bf16_t)f2bf(v);
        else if (col < 3072) ((bf16_t*)(ws + WS_V1))[(size_t)row * 1024 + col - 2048] = (bf16_t)f2bf(v);
        else ((bf16_t*)(ws + WS_ZG1))[(size_t)row * 1024 + col - 3072] = (bf16_t)f2bf(silu_f(v)); } };
__global__ void k_kr(Ptrs p) {
    const int idx = blockIdx.x * blockDim.x + threadIdx.x; if (idx >= M * 16) return;
    const int row = idx >> 4, i = idx & 15, s = ropeslot(i);
    const bf16_t* h = (const bf16_t*)(p.ws + WS_HY) + (size_t)row * D; const bf16_t* w1 = (const bf16_t*)(p.ws + WS_W0T) + (size_t)(640 + s) * D; const bf16_t* w2 = w1 + 4 * D;
    float a1 = 0.f, a2 = 0.f; for (int k = 0; k < D; ++k) { const float hv = bf2f(h[k]); a1 += hv * bf2f(w1[k]); a2 += hv * bf2f(w2[k]); }
    const float2 cs = ((const float2*)(p.ws + WS_RT))[idx]; const float o1 = a1 * cs.x - a2 * cs.y, o2 = a1 * cs.y + a2 * cs.x;
    bf16_t* km = (bf16_t*)(p.ws + WS_KM) + (size_t)row * 768 + 64 + s;
    for (int hh = 0; hh < 8; ++hh) { km[96 * hh] = (bf16_t)f2bf(o1); km[96 * hh + 4] = (bf16_t)f2bf(o2); }
}
__global__ void k_rstd(const bf16_t* src, int W, float* dst) {
    const int row = blockIdx.x * blockDim.x + threadIdx.x; if (row >= M) return;
    float s = 0.f; for (int k = 0; k < W; ++k) { const float v = bf2f(src[(size_t)row * W + k]); s += v * v; }
    dst[row] = 1.0f / sqrtf(s / W + NORM_EPS);
}
__global__ void k_ssqp(Ptrs p) {
    const int row = blockIdx.x * blockDim.x + threadIdx.x; if (row >= M) return;
    float* sq = (float*)(p.ws + WS_SSQ) + (size_t)row * 20; float s = 0.f;
    for (int k = 0; k < 384; ++k) { const float v = bf2f(((const bf16_t*)(p.ws + WS_CQ))[(size_t)row * 384 + k]); s += v * v; }
    sq[0] = s; for (int k = 1; k < 12; ++k) sq[k] = 0.f; s = 0.f;
    for (int k = 0; k < 256; ++k) { const float v = bf2f(((const bf16_t*)(p.ws + WS_CKV))[(size_t)row * 256 + k]); s += v * v; }
    sq[12] = s; for (int k = 13; k < 20; ++k) sq[k] = 0.f;
}
__global__ void k_qrope(Ptrs p) {
    const int idx = blockIdx.x * blockDim.x + threadIdx.x; if (idx >= M * 128) return;
    const int row = idx >> 7, hh = (idx >> 4) & 7, i = idx & 15, s = ropeslot(i), col = 96 * hh + 64 + s;
    const bf16_t* a = (const bf16_t*)(p.ws + WS_CQ) + (size_t)row * 384; const bf16_t* w1 = (const bf16_t*)(p.ws + WS_WUQT) + (size_t)col * 384; const bf16_t* w2 = w1 + 4 * 384;
    float a1 = 0.f, a2 = 0.f; for (int k = 0; k < 384; ++k) { const float av = bf2f(a[k]); a1 += av * bf2f(w1[k]); a2 += av * bf2f(w2[k]); }
    const float sc = ((const float*)(p.ws + WS_RSTD))[row] * C_MLA; a1 *= sc; a2 *= sc;
    const float2 cs = ((const float2*)(p.ws + WS_RT))[row * 16 + i];
    bf16_t* q = (bf16_t*)(p.ws + WS_QM) + (size_t)row * 768 + col; q[0] = (bf16_t)f2bf(a1 * cs.x - a2 * cs.y); q[4] = (bf16_t)f2bf(a1 * cs.y + a2 * cs.x);
}
__device__ __forceinline__ float blk_max64(float v) { for (int o = 32; o > 0; o >>= 1) v = fmaxf(v, __shfl_xor(v, o)); return v; }
__device__ __forceinline__ float blk_sum64(float v) { for (int o = 32; o > 0; o >>= 1) v += __shfl_xor(v, o); return v; }
__global__ void __launch_bounds__(64) k_mla(Ptrs p) {
    __shared__ float sc[SEQ];
    const int bid = blockIdx.x, t = bid % SEQ, h = (bid / SEQ) % 8, b = bid / (SEQ * 8), tid = threadIdx.x, row = b * SEQ + t;
    const int nk = (t / 64 + 1) * 64;
    const bf16_t* q = (const bf16_t*)(p.ws + WS_QM) + (size_t)row * 768 + 96 * h;
    float mx = -INFINITY;
    for (int s = tid; s < nk; s += 64) { const bf16_t* k = (const bf16_t*)(p.ws + WS_KM) + (size_t)(b * SEQ + s) * 768 + 96 * h; float a = 0.f; for (int d = 0; d < 96; ++d) a += bf2f(q[d]) * bf2f(k[d]); sc[s] = a; mx = fmaxf(mx, a); }
    mx = blk_max64(mx); float l = 0.f;
    for (int s = tid; s < nk; s += 64) { const float e = exp2f(sc[s] - mx); sc[s] = e; l += e; }
    l = blk_sum64(l); __syncthreads();
    float o = 0.f; const bf16_t* v = (const bf16_t*)(p.ws + WS_VM) + (size_t)(b * SEQ) * 512 + 64 * h + tid;
    for (int s = 0; s < nk; ++s) o += sc[s] * bf2f(v[(size_t)s * 512]);
    o /= l;
    const float zg = bf2f(((const bf16_t*)(p.ws + WS_ZG0))[(size_t)row * 1024 + 64 * h + tid]);
    ((bf16_t*)(p.ws + WS_HY))[(size_t)row * 1024 + 64 * h + tid] = (bf16_t)f2bf(o * zg);
}
__global__ void __launch_bounds__(64) k_sb(Ptrs p) {
    __shared__ float sc[SEQ], sp[SEQ];
    const int bid = blockIdx.x, t = bid % SEQ, h = (bid / SEQ) % 8, b = bid / (SEQ * 8), tid = threadIdx.x, row = b * SEQ + t;
    const bf16_t* q = (const bf16_t*)(p.ws + WS_QSB) + (size_t)row * 512 + 64 * h;
    for (int s = tid; s < t; s += 64) { const bf16_t* k = (const bf16_t*)(p.ws + WS_KSB) + (size_t)(b * SEQ + s) * 512 + 64 * h; float a = 0.f; for (int d = 0; d < 64; ++d) a += bf2f(q[d]) * bf2f(k[d]);
        sc[s] = a; sp[s] = fmaxf(a, 0.f) + log2f(1.0f + exp2f(-fabsf(a))); }
    __syncthreads();
    if (tid == 0) { float run = 0.f; for (int s = t - 1; s >= 0; --s) { run += sp[s]; sc[s] = exp2f(sc[s] - run); } }
    __syncthreads();
    float o = 0.f; const bf16_t* v = (const bf16_t*)(p.ws + WS_VSB) + (size_t)(b * SEQ) * 512 + 64 * h + tid;
    for (int s = 0; s < t; ++s) o += sc[s] * bf2f(v[(size_t)s * 512]);
    const float zg = bf2f(((const bf16_t*)(p.ws + WS_ZG0))[(size_t)row * 1024 + 512 + 64 * h + tid]);
    ((bf16_t*)(p.ws + WS_HY))[(size_t)row * 1024 + 512 + 64 * h + tid] = (bf16_t)f2bf(o * zg);
}
__global__ void __launch_bounds__(64) k_diff(Ptrs p) {
    __shared__ float s0[SEQ], s1[SEQ];
    const int bid = blockIdx.x, t = bid % SEQ, h = (bid / SEQ) % 8, b = bid / (SEQ * 8), tid = threadIdx.x, row = b * SEQ + t;
    const int nk = (t / 64 + 1) * 64;
    float d1 = p.lq1[tid] * p.lk1[tid], d2 = p.lq2[tid] * p.lk2[tid]; d1 = blk_sum64(d1); d2 = blk_sum64(d2);
    const float lam = expf(d1) - expf(d2) + LAM_INIT;
    const bf16_t* q = (const bf16_t*)(p.ws + WS_Q1) + (size_t)row * 1024 + 128 * h;
    float m0 = -INFINITY, m1 = -INFINITY;
    for (int s = tid; s < nk; s += 64) { const bf16_t* k = (const bf16_t*)(p.ws + WS_K1) + (size_t)(b * SEQ + s) * 1024 + 128 * h; float a0 = 0.f, a1 = 0.f;
        for (int d = 0; d < 64; ++d) { a0 += bf2f(q[d]) * bf2f(k[d]); a1 += bf2f(q[64 + d]) * bf2f(k[64 + d]); }
        const float bias = p.rel_table[t5_bucket(s - t) * 8 + h] * LOG2E; a0 += bias; a1 += bias; s0[s] = a0; s1[s] = a1; m0 = fmaxf(m0, a0); m1 = fmaxf(m1, a1); }
    m0 = blk_max64(m0); m1 = blk_max64(m1); float l0 = 0.f, l1 = 0.f;
    for (int s = tid; s < nk; s += 64) { const float e0 = exp2f(s0[s] - m0), e1 = exp2f(s1[s] - m1); s0[s] = e0; s1[s] = e1; l0 += e0; l1 += e1; }
    l0 = blk_sum64(l0); l1 = blk_sum64(l1); __syncthreads();
    const float r0 = 1.0f / l0, r1 = lam / l1;
    float oa = 0.f, ob = 0.f; const bf16_t* v = (const bf16_t*)(p.ws + WS_V1) + (size_t)(b * SEQ) * 1024 + 128 * h + tid;
    for (int s = 0; s < nk; ++s) { const float a = s0[s] * r0 - s1[s] * r1; oa += a * bf2f(v[(size_t)s * 1024]); ob += a * bf2f(v[(size_t)s * 1024 + 64]); }
    float ss = blk_sum64(oa * oa + ob * ob); const float rstd = 1.0f / sqrtf(ss / 128.0f + SUBLN_EPS) * (1.0f - LAM_INIT);
    const bf16_t* zg = (const bf16_t*)(p.ws + WS_ZG1) + (size_t)row * 1024 + 128 * h;
    bf16_t* y = (bf16_t*)(p.ws + WS_HY) + (size_t)row * 1024 + 128 * h;
    y[tid] = (bf16_t)f2bf(oa * rstd * p.subln_g[tid] * bf2f(zg[tid])); y[tid + 64] = (bf16_t)f2bf(ob * rstd * p.subln_g[tid + 64] * bf2f(zg[tid + 64]));
}
__global__ void k_final(Ptrs p) {
    __shared__ float red[256];
    const int row = blockIdx.x, tid = threadIdx.x; float* xr = p.out + (size_t)row * D; float v[4], s = 0.f;
    for (int j = 0; j < 4; ++j) { v[j] = xr[tid + 256 * j]; s += v[j] * v[j]; }
    red[tid] = s; __syncthreads();
    for (int o = 128; o > 0; o >>= 1) { if (tid < o) red[tid] += red[tid + o]; __syncthreads(); }
    const float rstd = 1.0f / sqrtf(red[0] / D + NORM_EPS);
    for (int j = 0; j < 4; ++j) xr[tid + 256 * j] = v[j] * rstd * p.final_g[tid + 256 * j];
}

static void run_phase(int ph, const Ptrs& p, hipStream_t st) {
    unsigned char* ws = p.ws;
    switch (ph) {
    case 0: { k_mod<<<(2 * BATCH * MOD_W + 255) / 256, 256, 0, st>>>(p);
              const size_t tot = (size_t)N0P * D + 768 * 384 + 1024 * 256 + (size_t)D * D * 2 + (size_t)DIFF_IN * D; k_wt<<<(unsigned)((tot + 255) / 256), 256, 0, st>>>(p);
              k_rt<<<M * 16 / 256, 256, 0, st>>>(p); } break;
    case 1: k_normmod<<<M, 256, 0, st>>>(p, p.x, 0); break;
    case 2: k_gemm<EG1><<<dim3(N0P / 64, M / 64), 256, 0, st>>>((const bf16_t*)(ws + WS_HY), D, (const bf16_t*)(ws + WS_W0T), M, N0P, D, EG1{ws});
            k_kr<<<M * 16 / 256, 256, 0, st>>>(p); break;
    case 3: k_rstd<<<M / 256, 256, 0, st>>>((const bf16_t*)(ws + WS_CQ), 384, (float*)(ws + WS_RSTD)); k_rstd<<<M / 256, 256, 0, st>>>((const bf16_t*)(ws + WS_CKV), 256, (float*)(ws + WS_RSTD) + M);
            k_gemm<EG2a><<<dim3(768 / 64, M / 64), 256, 0, st>>>((const bf16_t*)(ws + WS_CQ), 384, (const bf16_t*)(ws + WS_WUQT), M, 768, 384, EG2a{ws});
            k_qrope<<<M * 128 / 256, 256, 0, st>>>(p);
            k_gemm<EG2b><<<dim3(1024 / 64, M / 64), 256, 0, st>>>((const bf16_t*)(ws + WS_CKV), 256, (const bf16_t*)(ws + WS_WUKVT), M, 1024, 256, EG2b{ws}); break;
    case 4: k_mla<<<M * 8, 64, 0, st>>>(p); k_sb<<<M * 8, 64, 0, st>>>(p); break;
    case 5: k_gemm<EG3><<<dim3(D / 64, M / 64), 256, 0, st>>>((const bf16_t*)(ws + WS_HY), D, (const bf16_t*)(ws + WS_WO0T), M, D, D, EG3{ws, p.x, p.out, 0}); break;
    case 6: k_normmod<<<M, 256, 0, st>>>(p, p.out, 1); break;
    case 7: k_gemm<EG4><<<dim3(DIFF_IN / 64, M / 64), 256, 0, st>>>((const bf16_t*)(ws + WS_HY), D, (const bf16_t*)(ws + WS_W1T), M, DIFF_IN, D, EG4{ws}); break;
    case 8: k_diff<<<M * 8, 64, 0, st>>>(p); break;
    case 9: k_gemm<EG3><<<dim3(D / 64, M / 64), 256, 0, st>>>((const bf16_t*)(ws + WS_HY), D, (const bf16_t*)(ws + WS_WO1T), M, D, D, EG3{ws, p.out, p.out, 1}); break;
    case 10: k_final<<<M, 256, 0, st>>>(p); break;
    }
}
}
namespace pg8 {
#define PG8_LAS __attribute__((address_space(3)))
typedef unsigned short bf16_t;
typedef short bf16x8 __attribute__((ext_vector_type(8)));
typedef float f32x4 __attribute__((ext_vector_type(4)));
typedef unsigned u32x4 __attribute__((ext_vector_type(4)));
constexpr int BM = 256, BK = 64, HALF = 128, HTB = HALF * BK * 2  , STAGE_BYTES = 8 * HTB, NXCD = 8, WGM = 8;

__host__ __device__ __forceinline__ int lds_byte(int r, int c) { const int st = (r >> 4) * 2 + (c >> 5), rr = r & 15, cc = c & 31, ob = rr * 64 + cc * 2; return st * 1024 + (ob ^ (((ob >> 9) & 1) << 5)); }
__host__ __device__ __forceinline__ void stage_rc(int b, int& R, int& C) { const int st = b / 1024, sb = b % 1024, swz = sb ^ (((sb >> 9) & 1) << 5); R = (st >> 1) * 16 + swz / 64; C = (st & 1) * 32 + (swz % 64) / 2; }
__host__ __device__ __forceinline__ int perm32(int rho) { const int n = rho >> 4, i = rho & 15; return 8 * (i >> 2) + 4 * n + (i & 3); }

struct Unit { int pm, pn; };
struct Gemm { const bf16_t* A; const bf16_t* Bt; int M, N, K, lda; };

struct StaticOrder {
    int nM, nN, nwg, G, c;
    __host__ __device__ void init(int M, int N, int G_, int c_) { nM = M / BM; nN = N / BM; nwg = nM * nN; G = G_; c = c_; }
    __host__ __device__ bool next(int i, Unit& u) const {
        const long L = (long)i * G + c; if (L >= nwg) return false;
        int wgid = (int)L; { const int q = nwg / NXCD, r = nwg % NXCD, xcd = wgid % NXCD, off = wgid / NXCD; wgid = (xcd < r ? xcd * (q + 1) : r * (q + 1) + (xcd - r) * q) + off; }
        const int nig = WGM * nN, gid = wgid / nig, fm = gid * WGM, gsz = (nM - fm) < WGM ? (nM - fm) : WGM;
        u.pm = fm + ((wgid % nig) % gsz); u.pn = (wgid % nig) / gsz; return true;
    }
    __device__ __forceinline__ void a_ready(const Unit&) const {}
    __device__ __forceinline__ void done(const Unit&) const {}
};

__device__ __forceinline__ unsigned cvt_pk_bf16(float lo, float hi) { unsigned r; asm volatile("v_cvt_pk_bf16_f32 %0, %1, %2" : "=v"(r) : "v"(lo), "v"(hi)); return r; }
typedef float f32x2 __attribute__((ext_vector_type(2)));
template <class Epi, class Sched, bool ALIGN_EPI = false, bool SP2 = false>
__device__ __forceinline__ void gemm_phase(PG8_LAS unsigned char* lds, const Gemm g, const Sched& S, const Epi& E) {
    const int tid = threadIdx.x, wid = __builtin_amdgcn_readfirstlane(tid >> 6), lane = tid & 63, wr = wid >> 2, wc = wid & 3, fr = lane & 15, fq = lane >> 4;
    int K = g.K; asm volatile("" : "+s"(K)); const int nt = K / BK;
    unsigned voffA[2], voffB[2];
#pragma unroll
    for (int i = 0; i < 2; ++i) { int R, C; stage_rc(tid * 16 + i * 8192, R, C); const int Rb = Epi::PERM ? ((R & ~31) + perm32(R & 31)) : R;
        voffA[i] = (unsigned)(R * g.lda + C) * 2u; voffB[i] = (unsigned)(Rb * K + C) * 2u; }
    const size_t kstep = (size_t)(BK * 2);
    const size_t hstepA = (size_t)HALF * g.lda * 2, hstepB = (size_t)HALF * K * 2;
    const size_t tstepA = 2 * hstepA, tstepB = 2 * hstepB;
    const unsigned ldsw = (unsigned)wid * 1024u;
    const int aoff = lds_byte(wr * 64 + fr, fq * 8), boff = lds_byte(wc * 32 + fr, fq * 8);
#define PG8_SA(b, h) (((b) * 2 + (h)) * HTB)
#define PG8_SB(b, h) ((4 + (b) * 2 + (h)) * HTB)
#define PG8_STAGE(bufoff, gbase, voff) do { _Pragma("unroll") for (int _i = 0; _i < 2; ++_i) \
        __builtin_amdgcn_global_load_lds((const unsigned*)((const char*)(gbase) + (voff)[_i]), (PG8_LAS unsigned*)(lds + (bufoff) + ldsw + _i * 8192), 16, 0, 0); } while (0)
#define PG8_LDA(dst, b, h) do { _Pragma("unroll") for (int m = 0; m < 4; ++m) _Pragma("unroll") for (int k = 0; k < 2; ++k) dst[m][k] = *(const PG8_LAS bf16x8*)(lds + PG8_SA(b, h) + aoff + m * 2048 + k * 1024); } while (0)
#define PG8_LDB(dst, b, h) do { _Pragma("unroll") for (int n = 0; n < 2; ++n) _Pragma("unroll") for (int k = 0; k < 2; ++k) dst[n][k] = *(const PG8_LAS bf16x8*)(lds + PG8_SB(b, h) + boff + n * 2048 + k * 1024); } while (0)
#define PG8_MMA(ai, bj, At, Bt) do { __builtin_amdgcn_s_setprio(1); _Pragma("unroll") for (int m = 0; m < 4; ++m) _Pragma("unroll") for (int n = 0; n < 2; ++n) _Pragma("unroll") for (int k = 0; k < 2; ++k) \
        acc[ai][bj][m][n] = __builtin_amdgcn_mfma_f32_16x16x32_bf16(Bt[n][k], At[m][k], acc[ai][bj][m][n], 0, 0, 0); __builtin_amdgcn_s_setprio(0); } while (0)
#define PG8_WAIT_V(n) asm volatile("s_waitcnt vmcnt(" #n ")" ::: "memory")
#define PG8_WAIT_L(n) asm volatile("s_waitcnt lgkmcnt(" #n ")" ::: "memory")
#define PG8_BAR __builtin_amdgcn_s_barrier()
#define PG8_SCHED __builtin_amdgcn_sched_barrier(0)
    Unit cur, nxt; int ui = 0;
    if (!S.next(0, cur)) return;
    f32x4 acc[2][2][4][2];
#pragma unroll
    for (int a = 0; a < 2; ++a)
#pragma unroll
        for (int b = 0; b < 2; ++b)
#pragma unroll
            for (int m = 0; m < 4; ++m)
#pragma unroll
                for (int n = 0; n < 2; ++n) acc[a][b][m][n] = (f32x4){0.f, 0.f, 0.f, 0.f};
    bf16x8 At[4][2], B0[2][2], B1[2][2];
    const char* cA = (const char*)g.A + (size_t)cur.pm * tstepA; const char* cB = (const char*)g.Bt + (size_t)cur.pn * tstepB;
    S.a_ready(cur);
    if constexpr (SP2) {
        PG8_STAGE(PG8_SB(0, 0), cB, voffB); PG8_STAGE(PG8_SB(0, 1), cB + hstepB, voffB); PG8_STAGE(PG8_SA(0, 0), cA, voffA); PG8_STAGE(PG8_SA(0, 1), cA + hstepA, voffA);
        if (wr == 1) PG8_BAR;
        PG8_WAIT_V(2); PG8_BAR;
        PG8_STAGE(PG8_SB(1, 0), cB + kstep, voffB); PG8_STAGE(PG8_SA(1, 0), cA + kstep, voffA); PG8_STAGE(PG8_SB(1, 1), cB + hstepB + kstep, voffB);
        PG8_WAIT_V(6); PG8_BAR;
    } else {
        PG8_STAGE(PG8_SB(0, 0), cB, voffB); PG8_STAGE(PG8_SA(0, 0), cA, voffA); PG8_STAGE(PG8_SB(0, 1), cB + hstepB, voffB); PG8_STAGE(PG8_SA(0, 1), cA + hstepA, voffA);
        if (wr == 1) PG8_BAR;
        PG8_WAIT_V(4); PG8_BAR;
        PG8_STAGE(PG8_SB(1, 0), cB + kstep, voffB); PG8_STAGE(PG8_SA(1, 0), cA + kstep, voffA); PG8_STAGE(PG8_SB(1, 1), cB + hstepB + kstep, voffB);
        PG8_WAIT_V(6); PG8_BAR;
    }
    for (;;) {
        const bool has_next = S.next(ui + 1, nxt);
        const char* nA = has_next ? (const char*)g.A + (size_t)nxt.pm * tstepA : cA; const char* nB = has_next ? (const char*)g.Bt + (size_t)nxt.pn * tstepB : cB;
        for (int t = 0; t < nt; t += 2) {
            const bool last = (t == nt - 2);
            const char* a1 = cA + (size_t)(t + 1) * kstep;
            const char* a2 = last ? nA : cA + (size_t)(t + 2) * kstep; const char* b2 = last ? nB : cB + (size_t)(t + 2) * kstep;
            const char* a3 = a2 + kstep; const char* b3 = b2 + kstep;
            if (last && has_next) S.a_ready(nxt);
            if constexpr (SP2) {
            PG8_LDB(B0, 0, 0); PG8_LDB(B1, 0, 1); PG8_SCHED; PG8_LDA(At, 0, 0); PG8_STAGE(PG8_SA(1, 1), a1 + hstepA, voffA);
            PG8_WAIT_V(8); PG8_WAIT_L(0); PG8_BAR; PG8_MMA(0, 0, At, B0); PG8_MMA(0, 1, At, B1); PG8_BAR; PG8_SCHED;
            PG8_LDA(At, 0, 1); PG8_STAGE(PG8_SB(0, 0), b2, voffB); PG8_STAGE(PG8_SB(0, 1), b2 + hstepB, voffB); PG8_STAGE(PG8_SA(0, 0), a2, voffA);
            PG8_WAIT_V(8); PG8_WAIT_L(0); PG8_BAR; PG8_MMA(1, 0, At, B0); PG8_MMA(1, 1, At, B1); PG8_BAR; PG8_SCHED;
            PG8_LDB(B0, 1, 0); PG8_LDB(B1, 1, 1); PG8_SCHED; PG8_LDA(At, 1, 0); PG8_STAGE(PG8_SA(0, 1), a2 + hstepA, voffA);
            PG8_WAIT_V(8); PG8_WAIT_L(0); PG8_BAR; PG8_MMA(0, 0, At, B0); PG8_MMA(0, 1, At, B1); PG8_BAR; PG8_SCHED;
            PG8_LDA(At, 1, 1); PG8_STAGE(PG8_SB(1, 0), b3, voffB); PG8_STAGE(PG8_SB(1, 1), b3 + hstepB, voffB); PG8_STAGE(PG8_SA(1, 0), a3, voffA);
            PG8_WAIT_V(8); PG8_WAIT_L(0); PG8_BAR; PG8_MMA(1, 0, At, B0); PG8_MMA(1, 1, At, B1); PG8_BAR; PG8_SCHED;
            } else {
            PG8_LDB(B0, 0, 0); PG8_SCHED; PG8_LDA(At, 0, 0); PG8_STAGE(PG8_SA(1, 1), a1 + hstepA, voffA);
            PG8_WAIT_L(8); PG8_BAR; PG8_WAIT_L(0); PG8_MMA(0, 0, At, B0); PG8_BAR; PG8_SCHED;
            PG8_LDB(B1, 0, 1); PG8_STAGE(PG8_SB(0, 0), b2, voffB);
            PG8_BAR; PG8_WAIT_L(0); PG8_MMA(0, 1, At, B1); PG8_BAR;
            PG8_LDA(At, 0, 1); PG8_STAGE(PG8_SA(0, 0), a2, voffA);
            PG8_BAR; PG8_WAIT_L(0); PG8_MMA(1, 0, At, B0); PG8_BAR; PG8_SCHED;
            PG8_STAGE(PG8_SB(0, 1), b2 + hstepB, voffB);
            PG8_WAIT_V(6); PG8_BAR; PG8_MMA(1, 1, At, B1); PG8_BAR;
            PG8_LDB(B0, 1, 0); PG8_SCHED; PG8_LDA(At, 1, 0); PG8_STAGE(PG8_SA(0, 1), a2 + hstepA, voffA);
            PG8_WAIT_L(8); PG8_BAR; PG8_WAIT_L(0); PG8_MMA(0, 0, At, B0); PG8_BAR; PG8_SCHED;
            PG8_LDB(B1, 1, 1); PG8_STAGE(PG8_SB(1, 0), b3, voffB);
            PG8_BAR; PG8_WAIT_L(0); PG8_MMA(0, 1, At, B1); PG8_BAR;
            PG8_LDA(At, 1, 1); PG8_STAGE(PG8_SA(1, 0), a3, voffA);
            PG8_BAR; PG8_WAIT_L(0); PG8_MMA(1, 0, At, B0); PG8_BAR; PG8_SCHED;
            PG8_STAGE(PG8_SB(1, 1), b3 + hstepB, voffB);
            PG8_WAIT_V(6); PG8_BAR; PG8_MMA(1, 1, At, B1); PG8_BAR;
            }
        }
        if constexpr (ALIGN_EPI) { if (wr == 0) PG8_BAR; }
        if constexpr (!Epi::AFTER_DRAIN) { E(acc, cur, wr, wc, fr, fq); S.done(cur); }
        if (!has_next) break;
#pragma unroll
        for (int a = 0; a < 2; ++a)
#pragma unroll
            for (int b = 0; b < 2; ++b)
#pragma unroll
                for (int m = 0; m < 4; ++m)
#pragma unroll
                    for (int n = 0; n < 2; ++n) acc[a][b][m][n] = (f32x4){0.f, 0.f, 0.f, 0.f};
        cur = nxt; cA = nA; cB = nB; ++ui;
        if constexpr (ALIGN_EPI) { if (wr == 1) PG8_BAR; }
    }
    PG8_WAIT_V(0);
    if constexpr (!ALIGN_EPI) { if (wr == 0) PG8_BAR; }
    PG8_BAR;
    if constexpr (Epi::AFTER_DRAIN) { E.fused(acc, cur, wr, wc, fr, fq, lds, wid, lane); S.done(cur); }
#undef PG8_SA
#undef PG8_SB
#undef PG8_STAGE
#undef PG8_LDA
#undef PG8_LDB
#undef PG8_MMA
#undef PG8_WAIT_V
#undef PG8_WAIT_L
#undef PG8_BAR
#undef PG8_SCHED
}
}
#define GAS __attribute__((address_space(1)))
#define LAS __attribute__((address_space(3)))
typedef unsigned short bf16;
typedef unsigned v4u __attribute__((ext_vector_type(4)));
typedef float f32x4 __attribute__((ext_vector_type(4)));
typedef short bf16x8 __attribute__((ext_vector_type(8)));
typedef GAS unsigned gu32;
typedef GAS unsigned long long gu64;
#define RLX_AGENT __ATOMIC_RELAXED, __HIP_MEMORY_SCOPE_AGENT
#define LDS_WAIT() asm volatile("s_waitcnt lgkmcnt(0)" ::: "memory")
#define VM_WAIT() asm volatile("s_waitcnt vmcnt(0)" ::: "memory")
__device__ __forceinline__ unsigned long long rt() { return __builtin_amdgcn_s_memrealtime(); }

#define XB_TMO      128
#define XB_XCNT(j)  (256  + 64 * (j))
#define XB_XSUB(j)  (1280 + 64 * (j))
#define XB_XGEN(j)  (2304 + 64 * (j))
#define XB_TOP      3328
#define XB_TOPGEN   3392
#define XCD_BAR_WORDS 3456
#define XB_SPIN_CAP (1u << 18)

__device__ __forceinline__ unsigned xb_ld(unsigned* p)              { return __hip_atomic_load(p, __ATOMIC_RELAXED, __HIP_MEMORY_SCOPE_AGENT); }
__device__ __forceinline__ unsigned xb_add(unsigned* p, unsigned v) { return __hip_atomic_fetch_add(p, v, __ATOMIC_RELAXED, __HIP_MEMORY_SCOPE_AGENT); }
__device__ __forceinline__ unsigned xb_xcc_id() { return (unsigned)__builtin_amdgcn_s_getreg((3 << 11) | 20) & 0xFu; }
#define XB_SPIN(cond, bar) do { unsigned _sp = 0; while (cond) { __builtin_amdgcn_s_sleep(1); \
    if ((++_sp & 255u) == 0u) { if (xb_ld(&(bar)[XB_TMO])) break; if (_sp > XB_SPIN_CAP) { atomicAdd(&(bar)[XB_TMO], 1u); break; } } } } while (0)

struct XcdBarrier {
    unsigned* bar; unsigned x;
    volatile LAS unsigned* st;
};

__device__ __forceinline__ XcdBarrier xcd_barrier_post(unsigned* bar, volatile LAS unsigned* st) {
    XcdBarrier b; b.bar = bar; b.x = xb_xcc_id(); b.st = st;
    if (threadIdx.x == 0) (void)xb_add(&bar[XB_XCNT(b.x)], 1u);
    return b;
}
__device__ __forceinline__ void xcd_barrier_complete(unsigned* bar, unsigned x, unsigned& nloc, unsigned& nx) {
    const unsigned G = gridDim.x * gridDim.y * gridDim.z;
    unsigned sum, cnt, mine, sp = 0u;
    for (;;) {
        sum = 0u; cnt = 0u; mine = 0u;
#pragma unroll
        for (unsigned j = 0; j < 16; ++j) { const unsigned c = xb_ld(&bar[XB_XCNT(j)]); sum += c; cnt += (c > 0u) ? 1u : 0u; mine = (j == x) ? c : mine; }
        if (sum == G) break;
        __builtin_amdgcn_s_sleep(1);
        if ((++sp & 255u) == 0u) { if (xb_ld(&bar[XB_TMO])) break; if (sp > XB_SPIN_CAP) { atomicAdd(&bar[XB_TMO], 1u); break; } }
    }
    nloc = mine > 0u ? mine : 1u; nx = cnt > 0u ? cnt : 1u;
}

__device__ __forceinline__ void xcd_barrier(const XcdBarrier& b) {
    asm volatile("s_waitcnt vmcnt(0)" ::: "memory");
    __syncthreads();
    if (threadIdx.x == 0) {
        unsigned* bar = b.bar;
        __builtin_amdgcn_s_waitcnt(0);
        unsigned nloc = b.st[0], nx = b.st[1];
        if (nloc == 0u) { xcd_barrier_complete(bar, b.x, nloc, nx); b.st[0] = nloc; b.st[1] = nx; }
        const unsigned old = xb_add(&bar[XB_XSUB(b.x)], 1u);
        const unsigned gen = old / nloc;
        if (old + 1u == (gen + 1u) * nloc) {
            __builtin_amdgcn_fence(__ATOMIC_RELEASE, "agent");
            asm volatile("s_waitcnt vmcnt(0)" ::: "memory");
            const unsigned og = xb_add(&bar[XB_TOP], 1u);
            const unsigned tg = og / nx;
            if (og + 1u == (tg + 1u) * nx) xb_add(&bar[XB_TOPGEN], 1u);
            else XB_SPIN(xb_ld(&bar[XB_TOPGEN]) == tg, bar);
            __builtin_amdgcn_fence(__ATOMIC_ACQUIRE, "agent");
            xb_add(&bar[XB_XGEN(b.x)], 1u);
            asm volatile("s_waitcnt vmcnt(0)" ::: "memory");
        } else {
            XB_SPIN(xb_ld(&bar[XB_XGEN(b.x)]) == gen, bar);
            __builtin_amdgcn_fence(__ATOMIC_ACQUIRE, "agent");
            asm volatile("s_waitcnt vmcnt(0)" ::: "memory");
        }
    }
    __syncthreads();
}
constexpr int NWAVES = 8;
constexpr int RING_OFF = 0, RING_BYTES = 131072;
constexpr int LDSCTL_OFF = RING_BYTES, MISC_OFF = LDSCTL_OFF + 320;
constexpr int LDS_BYTES = 147456;
constexpr int CW_BAR = 4096;

namespace pg8 {
typedef unsigned u32x2 __attribute__((ext_vector_type(2)));
__device__ __forceinline__ float fast_silu(float v) { return v * __builtin_amdgcn_rcpf(1.0f + __expf(-v)); }
__device__ __forceinline__ u32x4 pack8(f32x4 a, f32x4 b) { u32x4 w; w.x = cvt_pk_bf16(a[0], a[1]); w.y = cvt_pk_bf16(a[2], a[3]); w.z = cvt_pk_bf16(b[0], b[1]); w.w = cvt_pk_bf16(b[2], b[3]); return w; }
__device__ __forceinline__ void rope4(const unsigned char* ws, int row, int i0, f32x4& x1, f32x4& x2) {
    const f32x4* rt = (const f32x4*)(ws + WS_RT) + ((size_t)row * 16 + i0) / 2;
    const f32x4 a = rt[0], b = rt[1];
    const f32x4 c = {a[0], a[2], b[0], b[2]}, s = {a[1], a[3], b[1], b[3]};
    const f32x4 o1 = x1 * c - x2 * s, o2 = x1 * s + x2 * c; x1 = o1; x2 = o2;
}
struct EpiG1 {
    static constexpr bool PERM = true, AFTER_DRAIN = false; unsigned char* ws;
    __device__ __forceinline__ void operator()(const f32x4 (&acc)[2][2][4][2], const Unit& u, int wr, int wc, int fr, int fq) const {
        const int row0 = u.pm * BM + wr * 64 + fr;
#pragma unroll
        for (int bj = 0; bj < 2; ++bj) {
            const int beta = 2 * u.pn + bj, cb = 32 * wc + 8 * fq;
            bf16_t* dst = nullptr; int ldc = 0, dcol = 0, kind = 0, slot = -1;
            if (beta < 3) { dst = (bf16_t*)(ws + WS_CQ); ldc = 384; dcol = 128 * beta + cb; slot = 4 * beta + wc; }
            else if (beta < 5) { dst = (bf16_t*)(ws + WS_CKV); ldc = 256; dcol = 128 * (beta - 3) + cb; slot = 12 + 4 * (beta - 3) + wc; }
            else if (beta == 5) { kind = (wc == 0) ? 3 : 4; }
            else if (beta < 10) { dst = (bf16_t*)(ws + WS_QSB); ldc = 512; dcol = 128 * (beta - 6) + cb; kind = 1; }
            else if (beta < 14) { dst = (bf16_t*)(ws + WS_KSB); ldc = 512; dcol = 128 * (beta - 10) + cb; kind = 5; }
            else if (beta < 18) { dst = (bf16_t*)(ws + WS_VSB); ldc = 512; dcol = 128 * (beta - 14) + cb; kind = 6; }
            else { dst = (bf16_t*)(ws + WS_ZG0); ldc = 1024; dcol = 128 * (beta - 18) + cb; kind = 2; }
            if (kind == 4) continue;
#pragma unroll
            for (int ai = 0; ai < 2; ++ai)
#pragma unroll
                for (int m = 0; m < 4; ++m) {
                    const int row = row0 + ai * HALF + m * 16; f32x4 v0 = acc[ai][bj][m][0], v1 = acc[ai][bj][m][1];
                    if (kind == 3) {
                        rope4(ws, row, 4 * fq, v0, v1); const u32x4 w = pack8(v0, v1);
                        bf16_t* km = (bf16_t*)(ws + WS_KM) + kimg_off(12, row >> 11, 0, row & 2047, 64 + 8 * fq);
#pragma unroll
                        for (int hh = 0; hh < 8; ++hh) *(u32x4*)(km + (size_t)hh * 32 * 12 * 512) = w;
                        continue;
                    }
                    if (slot >= 0) { float s = (v0[0] * v0[0] + v0[1] * v0[1]) + (v0[2] * v0[2] + v0[3] * v0[3]) + (v1[0] * v1[0] + v1[1] * v1[1]) + (v1[2] * v1[2] + v1[3] * v1[3]);
                        s += __shfl_xor(s, 16); s += __shfl_xor(s, 32); if (fq == 0) ((float*)(ws + WS_SSQ))[(size_t)row * 20 + slot] = s; }
                    if (kind == 1) { v0 = v0 * C_SB; v1 = v1 * C_SB; }
                    if (kind == 2) {
#pragma unroll
                        for (int e = 0; e < 4; ++e) { v0[e] = fast_silu(v0[e]); v1[e] = fast_silu(v1[e]); } }
                    size_t off = (size_t)row * ldc + dcol;
                    if (kind == 5) off = kimg_off(8, row >> 11, dcol >> 6, row & 2047, dcol & 63);
                    if (kind == 6) off = vimg_off(2, row >> 11, dcol >> 6, row & 2047, dcol & 63);
                    *(u32x4*)(dst + off) = pack8(v0, v1);
                }
        }
    }
};
struct EpiUQ {
    static constexpr bool PERM = true, AFTER_DRAIN = false; unsigned char* ws;
    __device__ __forceinline__ void operator()(const f32x4 (&acc)[2][2][4][2], const Unit& u, int wr, int wc, int fr, int fq) const {
        const int row0 = u.pm * BM + wr * 64 + fr;
#pragma unroll
        for (int ai = 0; ai < 2; ++ai)
#pragma unroll
            for (int m = 0; m < 4; ++m) {
                int row = row0 + ai * HALF + m * 16; asm volatile("" : "+v"(row));
                const f32x4* sq = (const f32x4*)((const float*)(ws + WS_SSQ) + (size_t)row * 20); const f32x4 a = sq[0], b = sq[1], c = sq[2];
                const float ssq = ((a[0] + a[1]) + (a[2] + a[3])) + ((b[0] + b[1]) + (b[2] + b[3])) + ((c[0] + c[1]) + (c[2] + c[3]));
                const float sc = C_MLA / sqrtf(ssq * (1.0f / 384.0f) + NORM_EPS);
#pragma unroll
                for (int bj = 0; bj < 2; ++bj) {
                    const int c0 = u.pn * BM + bj * HALF + 32 * wc + 8 * fq, hh = c0 / 96, j = c0 - 96 * hh;
                    f32x4 v0 = acc[ai][bj][m][0] * sc, v1 = acc[ai][bj][m][1] * sc;
                    if (j >= 64) rope4(ws, row, 4 * ((j - 64) >> 3), v0, v1);
                    *(u32x4*)((bf16_t*)(ws + WS_QM) + (size_t)row * 768 + c0) = pack8(v0, v1);
                }
                asm volatile("" ::: "memory");
            }
    }
};
struct EpiUKV {
    static constexpr bool PERM = true, AFTER_DRAIN = false; unsigned char* ws;
    __device__ __forceinline__ void operator()(const f32x4 (&acc)[2][2][4][2], const Unit& u, int wr, int wc, int fr, int fq) const {
        const int row0 = u.pm * BM + wr * 64 + fr, jj = 32 * wc + 8 * fq;
#pragma unroll
        for (int ai = 0; ai < 2; ++ai)
#pragma unroll
            for (int m = 0; m < 4; ++m) {
                int row = row0 + ai * HALF + m * 16; asm volatile("" : "+v"(row));
                const f32x4* sq = (const f32x4*)((const float*)(ws + WS_SSQ) + (size_t)row * 20 + 12); const f32x4 a = sq[0], b = sq[1];
                const float ssq = ((a[0] + a[1]) + (a[2] + a[3])) + ((b[0] + b[1]) + (b[2] + b[3]));
                const float sc = 1.0f / sqrtf(ssq * (1.0f / 256.0f) + NORM_EPS);
#pragma unroll
                for (int bj = 0; bj < 2; ++bj) {
                    const int hh = 2 * u.pn + bj;
                    bf16_t* dst = (wc < 2) ? (bf16_t*)(ws + WS_KM) + kimg_off(12, row >> 11, hh, row & 2047, jj) : (bf16_t*)(ws + WS_VM) + vimg_off(2, row >> 11, hh, row & 2047, jj - 64);
                    *(u32x4*)dst = pack8(acc[ai][bj][m][0] * sc, acc[ai][bj][m][1] * sc);
                }
                asm volatile("" ::: "memory");
            }
    }
};
struct EpiOut {
    static constexpr bool PERM = false, AFTER_DRAIN = false; const float* xin; float* xout; const float* gate;
    __device__ __forceinline__ void operator()(const f32x4 (&acc)[2][2][4][2], const Unit& u, int wr, int wc, int fr, int fq) const {
        const int row0 = u.pm * BM + wr * 64 + fr, b = (u.pm * BM) / SEQ, col0 = u.pn * BM + wc * 32 + 4 * fq;
        f32x4 gv[2][2];
#pragma unroll
        for (int bj = 0; bj < 2; ++bj)
#pragma unroll
            for (int n = 0; n < 2; ++n) gv[bj][n] = *(const f32x4*)(gate + (size_t)b * MOD_W + col0 + bj * HALF + n * 16);
#pragma unroll
        for (int ai = 0; ai < 2; ++ai)
#pragma unroll
            for (int m = 0; m < 4; ++m) { const size_t off = (size_t)(row0 + ai * HALF + m * 16) * D + col0;
#pragma unroll
                for (int bj = 0; bj < 2; ++bj)
#pragma unroll
                    for (int n = 0; n < 2; ++n) { const f32x4 xv = *(const f32x4*)(xin + off + bj * HALF + n * 16); *(f32x4*)(xout + off + bj * HALF + n * 16) = xv + gv[bj][n] * acc[ai][bj][m][n]; } }
    }
};
struct EpiG4 {
    static constexpr bool PERM = true, AFTER_DRAIN = false; unsigned char* ws;
    __device__ __forceinline__ void operator()(const f32x4 (&acc)[2][2][4][2], const Unit& u, int wr, int wc, int fr, int fq) const {
        const int row0 = u.pm * BM + wr * 64 + fr, which = u.pn >> 2;
        bf16_t* dst = (bf16_t*)(ws + (which == 0 ? WS_Q1 : which == 1 ? WS_K1 : which == 2 ? WS_V1 : WS_ZG1));
#pragma unroll
        for (int bj = 0; bj < 2; ++bj) { const int dcol = 256 * (u.pn & 3) + bj * HALF + 32 * wc + 8 * fq;
#pragma unroll
            for (int ai = 0; ai < 2; ++ai)
#pragma unroll
                for (int m = 0; m < 4; ++m) { const int row = row0 + ai * HALF + m * 16; f32x4 v0 = acc[ai][bj][m][0], v1 = acc[ai][bj][m][1];
                    if (which == 0) { v0 = v0 * C_SB; v1 = v1 * C_SB; }
                    if (which == 3) {
#pragma unroll
                        for (int e = 0; e < 4; ++e) { v0[e] = fast_silu(v0[e]); v1[e] = fast_silu(v1[e]); } }
                    size_t off = (size_t)row * 1024 + dcol;
                    if (which == 1) off = kimg_off(16, row >> 11, dcol >> 7, row & 2047, dcol & 127);
                    if (which == 2) off = vimg_off(4, row >> 11, dcol >> 7, row & 2047, dcol & 127);
                    *(u32x4*)(dst + off) = pack8(v0, v1); } }
    }
};
}

struct Frame { LAS unsigned char* lds; volatile LAS unsigned* MISC; gu32* ctl; int tid, lane, wave, vcu, G; };
__device__ __forceinline__ float wave_sum(float v) {
#pragma unroll
    for (int o = 1; o < 64; o <<= 1) v += __shfl_xor(v, o);
    return v;
}
__device__ __forceinline__ int msrc(int mat, int n) { return mat == 0 ? w0_src(n) : mat == 1 ? wuq_src(n) : n; }
__device__ __forceinline__ void p0_transpose_item(const float* W, int K, int Nsrc, bf16_t* WT, int Nout, int mat, const float* rowscale, LAS float* scr, int item, int lane) {
    const int nblk = Nout / 32, kb = item / nblk, nb = item % nblk, k0 = 64 * kb, n0 = 32 * nb;
    const int s = msrc(mat, n0 + (lane & 31));
#pragma unroll 8
    for (int i = 0; i < 32; ++i) { const int kk = 2 * i + (lane >> 5); float v = 0.f; if (s >= 0) { v = W[(size_t)(k0 + kk) * Nsrc + s]; if (rowscale) v *= rowscale[k0 + kk]; } scr[kk * 33 + (lane & 31)] = v; }
    LDS_WAIT(); asm volatile("" ::: "memory");
    const int c = lane & 7;
#pragma unroll
    for (int j = 0; j < 4; ++j) { const int n = (lane >> 3) + 8 * j; const LAS float* sp = scr + (8 * c) * 33 + n;
        v4u o; o.x = pk2(sp[0 * 33], sp[1 * 33]); o.y = pk2(sp[2 * 33], sp[3 * 33]); o.z = pk2(sp[4 * 33], sp[5 * 33]); o.w = pk2(sp[6 * 33], sp[7 * 33]);
        *(GAS v4u*)(WT + (size_t)(n0 + n) * K + k0 + 8 * c) = o; }
    LDS_WAIT(); asm volatile("" ::: "memory");
}
__device__ __forceinline__ void p0_prologue(Frame& F, const Ptrs& p) {
    const int gw = F.vcu * NWAVES + F.wave, NGW = F.G * NWAVES, lane = F.lane;
    float* MOD = (float*)(p.ws + WS_MOD);
    for (int it = gw; it < 2 * 48 * 16; it += NGW) {
        const int i = it / 768, r = it % 768, n0 = (r >> 4) * 64, ks = r & 15, k0 = ks * 64;
        float sc[8], acc[8];
#pragma unroll
        for (int b = 0; b < 8; ++b) { sc[b] = silu_f(p.c[b * D + k0 + lane]); acc[b] = 0.f; }
        const float* w = p.ada_w + ((size_t)i * D + k0) * MOD_W + n0 + lane;
#pragma unroll 8
        for (int kk = 0; kk < 64; ++kk) { const float wv = w[(size_t)kk * MOD_W];
#pragma unroll
            for (int b = 0; b < 8; ++b) acc[b] += __builtin_bit_cast(float, __builtin_amdgcn_readlane(__builtin_bit_cast(int, sc[b]), kk)) * wv; }
        const float bias = (ks == 0) ? p.ada_b[i * MOD_W + n0 + lane] : 0.f;
#pragma unroll
        for (int b = 0; b < 8; ++b) atomicAdd(MOD + (size_t)(i * BATCH + b) * MOD_W + n0 + lane, acc[b] + bias);
    }
    LAS float* scr = (LAS float*)(F.lds + RING_OFF + F.wave * 16384);
    constexpr int I0 = 16 * (N0P / 32), I1 = 6 * 24, I2 = 4 * 32, I3 = 16 * 32, I4 = 16 * (DIFF_IN / 32), I5 = 16 * 32, NIT = I0 + I1 + I2 + I3 + I4 + I5;
    for (int it = gw; it < NIT; it += NGW) {
        int r = it;
        if (r < I0) { p0_transpose_item(p.ab_w_in, D, AB_IN, (bf16_t*)(p.ws + WS_W0T), N0P, 0, nullptr, scr, r, lane); continue; } r -= I0;
        if (r < I1) { p0_transpose_item(p.ab_w_uq, 384, 768, (bf16_t*)(p.ws + WS_WUQT), 768, 1, p.ab_q_norm_g, scr, r, lane); continue; } r -= I1;
        if (r < I2) { p0_transpose_item(p.ab_w_ukv, 256, 1024, (bf16_t*)(p.ws + WS_WUKVT), 1024, 2, p.ab_kv_norm_g, scr, r, lane); continue; } r -= I2;
        if (r < I3) { p0_transpose_item(p.ab_w_out, D, D, (bf16_t*)(p.ws + WS_WO0T), D, 2, nullptr, scr, r, lane); continue; } r -= I3;
        if (r < I4) { p0_transpose_item(p.dif_w_in, D, DIFF_IN, (bf16_t*)(p.ws + WS_W1T), DIFF_IN, 2, nullptr, scr, r, lane); continue; } r -= I4;
        p0_transpose_item(p.dif_w_out, D, D, (bf16_t*)(p.ws + WS_WO1T), D, 2, nullptr, scr, r, lane);
    }
    for (int idx = F.vcu * NWAVES * 64 + F.tid; idx < M * 16; idx += F.G * NWAVES * 64) {
        const int row = idx >> 4, i = idx & 15, b = row / SEQ, t = row % SEQ;
        const float pos = (float)(p.pos_offset[b] + t), inv = powf(10000.0f, -(float)i / 16.0f), ang = pos * inv;
        float s, c; sincosf(ang, &s, &c);
        ((float2*)(p.ws + WS_RT))[idx] = make_float2(c, s);
    }
}
__device__ __forceinline__ void normmod_phase(Frame& F, const Ptrs& p, const float* xin, int layer) {
    const int gw = F.vcu * NWAVES + F.wave, NGW = F.G * NWAVES, lane = F.lane;
    const float* MOD = (const float*)(p.ws + WS_MOD);
    for (int rg = gw; rg < M / 8; rg += NGW) {
        const int b = (rg * 8) / SEQ; const float* mod = MOD + (size_t)(layer * BATCH + b) * MOD_W;
        f32x4 gs[4], sh[4];
#pragma unroll
        for (int j = 0; j < 4; ++j) { const int c = 4 * lane + 256 * j; const f32x4 g = *(const f32x4*)(p.norm_g + layer * D + c), s = *(const f32x4*)(mod + D + c); gs[j] = g * (s + 1.0f); sh[j] = *(const f32x4*)(mod + c); }
        for (int rr = 0; rr < 8; ++rr) { const int row = rg * 8 + rr;
            const GAS f32x4* xr = (const GAS f32x4*)(xin + (size_t)row * D) + lane; f32x4 v[4]; float s = 0.f;
#pragma unroll
            for (int j = 0; j < 4; ++j) { v[j] = xr[64 * j]; s += (v[j].x * v[j].x + v[j].y * v[j].y) + (v[j].z * v[j].z + v[j].w * v[j].w); }
            const float rstd = 1.0f / sqrtf(wave_sum(s) * (1.0f / D) + NORM_EPS);
            GAS unsigned long long* o8 = (GAS unsigned long long*)((bf16_t*)(p.ws + WS_HY) + (size_t)row * D) + lane;
#pragma unroll
            for (int j = 0; j < 4; ++j) { const f32x4 o = v[j] * rstd * gs[j] + sh[j]; o8[64 * j] = (unsigned long long)pk2(o.x, o.y) | ((unsigned long long)pk2(o.z, o.w) << 32); }
        }
    }
}
__device__ __forceinline__ void final_phase(Frame& F, const Ptrs& p) {
    const int gw = F.vcu * NWAVES + F.wave, NGW = F.G * NWAVES, lane = F.lane;
    f32x4 g[4];
#pragma unroll
    for (int j = 0; j < 4; ++j) g[j] = *(const f32x4*)(p.final_g + 4 * lane + 256 * j);
    for (int row = gw; row < M; row += NGW) {
        GAS f32x4* xr = (GAS f32x4*)(p.out + (size_t)row * D) + lane; f32x4 v[4]; float s = 0.f;
#pragma unroll
        for (int j = 0; j < 4; ++j) { v[j] = xr[64 * j]; s += (v[j].x * v[j].x + v[j].y * v[j].y) + (v[j].z * v[j].z + v[j].w * v[j].w); }
        const float rstd = 1.0f / sqrtf(wave_sum(s) * (1.0f / D) + NORM_EPS);
#pragma unroll
        for (int j = 0; j < 4; ++j) xr[64 * j] = v[j] * rstd * g[j];
    }
}
namespace at {
typedef short bf16x8 __attribute__((ext_vector_type(8)));
typedef short s16x4 __attribute__((ext_vector_type(4)));
typedef short v4i16_t __attribute__((ext_vector_type(4)));
typedef float f32x16 __attribute__((ext_vector_type(16)));
typedef float f32x4 __attribute__((ext_vector_type(4)));
typedef float f32x2_t __attribute__((ext_vector_type(2)));
typedef __bf16 bf16x2_t __attribute__((ext_vector_type(2)));
typedef unsigned u32x4 __attribute__((ext_vector_type(4)));
typedef unsigned u32x2 __attribute__((ext_vector_type(2)));
typedef LAS const unsigned char* lcp;
typedef LAS unsigned char* lp;
#define MFMA32(a, b, c) __builtin_amdgcn_mfma_f32_32x32x16_bf16(a, b, c, 0, 0, 0)
constexpr float THR = 8.0f;
constexpr float SB_DONE = 150.0f;

__device__ __forceinline__ int crow(int r, int hi) { return (r & 3) + 8 * (r >> 2) + 4 * hi; }
__device__ __forceinline__ unsigned cvtpk(float lo, float hi) { f32x2_t v = {lo, hi}; bf16x2_t b = __builtin_convertvector(v, bf16x2_t); return __builtin_bit_cast(unsigned, b); }
__device__ __forceinline__ s16x4 vtr(lcp p) { return __builtin_bit_cast(s16x4, __builtin_amdgcn_ds_read_tr16_b64_v4i16((LAS v4i16_t*)p)); }
__device__ __forceinline__ float xmax(float m) { auto rr = __builtin_amdgcn_permlane32_swap(__float_as_uint(m), __float_as_uint(m), false, false); return fmaxf(__uint_as_float(rr[0]), __uint_as_float(rr[1])); }
__device__ __forceinline__ float xsum(float m) { auto rr = __builtin_amdgcn_permlane32_swap(__float_as_uint(m), __float_as_uint(m), false, false); return __uint_as_float(rr[0]) + __uint_as_float(rr[1]); }
__device__ __forceinline__ void xboth(float v, float& lo, float& hi) { auto rr = __builtin_amdgcn_permlane32_swap(__float_as_uint(v), __float_as_uint(v), false, false); lo = __uint_as_float(rr[0]); hi = __uint_as_float(rr[1]); }
__device__ __forceinline__ void glds16(const void* gsrc, unsigned lds_dst) { unsigned keep;
    asm volatile("s_mov_b32 %0, m0\n\ts_mov_b32 m0, %2\n\ts_nop 0\n\tglobal_load_lds_dwordx4 %1, off\n\ts_mov_b32 m0, %0" : "=&s"(keep) : "v"(gsrc), "s"(lds_dst) : "memory"); }
#define AT_WAIT_BAR(N) asm volatile("s_waitcnt vmcnt(" #N ") lgkmcnt(0)\n\ts_barrier" ::: "memory")
#define AT_BAR() asm volatile("s_waitcnt lgkmcnt(0)\n\ts_barrier" ::: "memory")

template <int ND0> __device__ __forceinline__ void qk_tile(f32x16& p0, f32x16& p1, lcp kslot, const bf16x8* qr, const f32x16& cinit, int r32, int hi) {
    const lcp kb = kslot + hi * 1024 + r32 * 16;
#pragma unroll
    for (int d0 = 0; d0 < ND0; ++d0) {
        const bf16x8 b0 = *(const LAS bf16x8*)(kb + d0 * 2048), b1 = *(const LAS bf16x8*)(kb + d0 * 2048 + 512);
        p0 = MFMA32(b0, qr[d0], d0 == 0 ? cinit : p0); p1 = MFMA32(b1, qr[d0], d0 == 0 ? cinit : p1); }
}
__device__ __forceinline__ void pack_p(const f32x16& p0, const f32x16& p1, u32x4 (&pw)[4]) {
    pw[0] = (u32x4){cvtpk(p0[0], p0[1]), cvtpk(p0[2], p0[3]), cvtpk(p0[4], p0[5]), cvtpk(p0[6], p0[7])};
    pw[1] = (u32x4){cvtpk(p0[8], p0[9]), cvtpk(p0[10], p0[11]), cvtpk(p0[12], p0[13]), cvtpk(p0[14], p0[15])};
    pw[2] = (u32x4){cvtpk(p1[0], p1[1]), cvtpk(p1[2], p1[3]), cvtpk(p1[4], p1[5]), cvtpk(p1[6], p1[7])};
    pw[3] = (u32x4){cvtpk(p1[8], p1[9]), cvtpk(p1[10], p1[11]), cvtpk(p1[12], p1[13]), cvtpk(p1[14], p1[15])};
}
template <int NDB> __device__ __forceinline__ void pv_tile(f32x16* o, lcp vslot, int lane, int hi, const u32x4 (&pw)[4]) {
    const lcp vb = vslot + ((lane >> 4) & 1) * 32 + (lane & 3) * 8 + (4 * hi + ((lane & 15) >> 2)) * 64;
#pragma unroll
    for (int db = 0; db < NDB; ++db)
#pragma unroll
        for (int ks = 0; ks < 4; ++ks) {
            const s16x4 lo = vtr(vb + db * 4096 + ks * 1024), hh = vtr(vb + db * 4096 + ks * 1024 + 512);
            const bf16x8 bfrag = {lo[0], lo[1], lo[2], lo[3], hh[0], hh[1], hh[2], hh[3]};
            o[db] = MFMA32(__builtin_bit_cast(bf16x8, pw[ks]), bfrag, o[db]); }
}
__device__ __forceinline__ float rowmax32(const f32x16& p0, const f32x16& p1) {
    float a = __builtin_fmaxf(__builtin_fmaxf(p0[0], p0[1]), p1[0]), b = __builtin_fmaxf(__builtin_fmaxf(p0[2], p0[3]), p1[1]); a = __builtin_fmaxf(__builtin_fmaxf(a, p1[2]), p1[3]);
#pragma unroll
    for (int r = 4; r < 16; r += 4) { a = __builtin_fmaxf(__builtin_fmaxf(a, p0[r]), p0[r + 1]); b = __builtin_fmaxf(__builtin_fmaxf(b, p0[r + 2]), p0[r + 3]);
        a = __builtin_fmaxf(__builtin_fmaxf(a, p1[r]), p1[r + 1]); b = __builtin_fmaxf(__builtin_fmaxf(b, p1[r + 2]), p1[r + 3]); }
    return xmax(__builtin_fmaxf(a, b));
}
template <int NDB> __device__ __forceinline__ void softmax_half(f32x16& p0, f32x16& p1, float& mhat, float& l, f32x16* o, bool first, LAS float* wsf, int r32, int hi) {
    const float rm = rowmax32(p0, p1);
    if (first || __any(rm > THR)) {
        const float dl = first ? rm : __builtin_fmaxf(rm, 0.f); mhat += dl;
#pragma unroll
        for (int r = 0; r < 16; ++r) { p0[r] -= dl; p1[r] -= dl; }
        if (!first) {
            const float f = __builtin_amdgcn_exp2f(-dl); l *= f;
            if (hi == 0) wsf[r32] = f;
#pragma unroll
            for (int r = 0; r < 16; ++r) { const float fr_ = wsf[crow(r, hi)];
#pragma unroll
                for (int db = 0; db < NDB; ++db) o[db][r] *= fr_; }
        }
    }
    float s = 0.f;
#pragma unroll
    for (int r = 0; r < 16; ++r) { p0[r] = __builtin_amdgcn_exp2f(p0[r]); p1[r] = __builtin_amdgcn_exp2f(p1[r]); s += p0[r] + p1[r]; }
    l += s;
}
__device__ __forceinline__ void store_o64(const f32x16* o, const float* rs, LAS float* stg, const bf16_t* zg, bf16_t* y, int lane, int r32, int hi) {
#pragma unroll
    for (int r = 0; r < 16; ++r) { const int orow = crow(r, hi); stg[orow * 64 + r32] = o[0][r] * rs[r]; stg[orow * 64 + 32 + r32] = o[1][r] * rs[r]; }
#pragma unroll
    for (int i = 0; i < 4; ++i) { const int row = i * 8 + (lane >> 3), ch = lane & 7;
        const f32x4 a = *(const LAS f32x4*)(stg + row * 64 + ch * 8), b = *(const LAS f32x4*)(stg + row * 64 + ch * 8 + 4);
        const u32x4 z = *(const u32x4*)(zg + (size_t)row * 1024 + ch * 8);
        u32x4 w; w.x = cvtpk(a[0] * bf2f(z.x & 0xffffu), a[1] * bf2f(z.x >> 16)); w.y = cvtpk(a[2] * bf2f(z.y & 0xffffu), a[3] * bf2f(z.y >> 16));
        w.z = cvtpk(b[0] * bf2f(z.z & 0xffffu), b[1] * bf2f(z.z >> 16)); w.w = cvtpk(b[2] * bf2f(z.w & 0xffffu), b[3] * bf2f(z.w >> 16));
        *(u32x4*)(y + (size_t)row * 1024 + ch * 8) = w; }
}

constexpr int AT_WSF = 132096, AT_LUT = 134144, AT_FLAG = 135168;
template <bool DIFF, int VAR = 0> __device__ __forceinline__ void sm_unit(const Ptrs& p, lp lds, int b, int h, int qb) {
    bf16_t* const ybase = (bf16_t*)(p.ws + (VAR ? (size_t)224 * MiB : WS_HY));
    constexpr int PD = DIFF ? 2 : 3, NS = PD + 2;
    constexpr int ND0 = DIFF ? 4 : 6, NDB = DIFF ? 4 : 2, KSLOT = DIFF ? 16384 : 12288, VSLOT = DIFF ? 16384 : 8192, SLOT = KSLOT + VSLOT, QROWS = DIFF ? 128 : 256;
    constexpr int QP = DIFF ? 1024 : 768;
    const int tid = threadIdx.x, lane = tid & 63, r32 = lane & 31, hi = lane >> 5, wid = __builtin_amdgcn_readfirstlane(tid >> 6), grp = wid >> 2;
    const int rg = DIFF ? (wid & 3) : wid, cc = DIFF ? (wid >> 2) : 0;
    const size_t rowbase = (size_t)b * SEQ; const int q0 = qb * QROWS, qlo = q0 + rg * 32;
    const bf16_t* Qw = (const bf16_t*)(p.ws + (DIFF ? WS_Q1 : WS_QM)) + (rowbase + qlo) * QP + (DIFF ? h * 128 + cc * 64 : h * 96);
    const int NT = (q0 + QROWS) / 64, mylast = qlo / 64;
    LAS float* wsf = (LAS float*)(lds + AT_WSF) + wid * 64;
    LAS float* lut = (LAS float*)(lds + AT_LUT);
    const unsigned lds0 = (unsigned)(size_t)lds;
    constexpr int KT = KSLOT / 2, VT = VSLOT / 2;
    const bf16_t* Kt = (const bf16_t*)(p.ws + (DIFF ? WS_K1 : WS_KM)) + (size_t)((b * 8 + h) * 32) * KT + lane * 8;
    const bf16_t* Vt = (const bf16_t*)(p.ws + (DIFF ? WS_V1 : WS_VM)) + (size_t)((b * 8 + h) * 32) * VT + lane * 8;
    const int kp2 = DIFF ? 8 + wid : 8 + (wid & 3);
    const unsigned kd1 = lds0 + wid * 1024, kd2 = lds0 + kp2 * 1024, vd1 = lds0 + KSLOT + wid * 1024;
#define SM_STAGE(t) do { const unsigned so_ = (unsigned)(((t) % NS) * SLOT); const bf16_t* kt_ = Kt + (size_t)(t) * KT; const bf16_t* vt_ = Vt + (size_t)(t) * VT; \
        glds16(kt_ + wid * 512, (unsigned)__builtin_amdgcn_readfirstlane(kd1 + so_)); glds16(kt_ + kp2 * 512, (unsigned)__builtin_amdgcn_readfirstlane(kd2 + so_)); \
        glds16(vt_ + wid * 512, (unsigned)__builtin_amdgcn_readfirstlane(vd1 + so_)); if (DIFF) glds16(vt_ + (8 + wid) * 512, (unsigned)__builtin_amdgcn_readfirstlane(vd1 + so_ + 8192)); } while (0)
#define SM_WAITBAR(full) do { if ((full) && !(VAR & 2)) { if (DIFF) AT_WAIT_BAR(4); else AT_WAIT_BAR(6); } else AT_WAIT_BAR(0); } while (0)
    asm volatile("s_waitcnt vmcnt(0)" ::: "memory");
    for (int t = 0; t < PD && t < NT; ++t) SM_STAGE(t);
    float lam = 0.f, bfar = 0.f;
    if (DIFF) {
        if (tid < 249) lut[tid] = p.rel_table[t5_bucket(tid - 185) * 8 + h] * LOG2E;
        bfar = p.rel_table[15 * 8 + h] * LOG2E;
        float d1 = p.lq1[lane] * p.lk1[lane], d2 = p.lq2[lane] * p.lk2[lane]; d1 = wave_sum(d1); d2 = wave_sum(d2); lam = __expf(d1) - __expf(d2) + LAM_INIT;
    }
    bf16x8 qr[ND0];
#pragma unroll
    for (int d0 = 0; d0 < ND0; ++d0) qr[d0] = *(const bf16x8*)(Qw + (size_t)r32 * QP + d0 * 16 + hi * 8);
    f32x16 o[NDB];
#pragma unroll
    for (int db = 0; db < NDB; ++db) o[db] = f32x16{};
    float mhat = 0.f, l = 0.f; f32x16 p0 = {}, p1 = {}; u32x4 pw[4] = {};
    if (grp == 1) SM_WAITBAR(NT >= PD);
    for (int t = 0; t < NT; ++t) {
        SM_WAITBAR(t + PD <= NT);
        if (t + PD < NT && !(VAR & 2)) SM_STAGE(t + PD);
        const lcp slot = (lcp)(lds + (t % NS) * SLOT);
        if (t > 0 && t - 1 <= mylast && !(VAR & 1)) pv_tile<NDB>(o, (lcp)(lds + ((t - 1) % NS) * SLOT + KSLOT), lane, hi, pw);
        const bool far = DIFF && (64 * t + 63 - qlo <= -91);
        if (t <= mylast && !(VAR & 1)) { f32x16 ci;
#pragma unroll
            for (int r = 0; r < 16; ++r) ci[r] = (far ? bfar : 0.f) - mhat;
            qk_tile<ND0>(p0, p1, slot + cc * 8192, qr, ci, r32, hi); }
        SM_WAITBAR(t + PD <= NT - 1);
        if (t <= mylast && !(VAR & 1)) {
            if (DIFF && !far) { const LAS float* lb = lut + (64 * t - qlo + 185 - r32 + 4 * hi);
#pragma unroll
                for (int r = 0; r < 16; ++r) { p0[r] += lb[8 * (r >> 2) + (r & 3)]; p1[r] += lb[32 + 8 * (r >> 2) + (r & 3)]; } }
            softmax_half<NDB>(p0, p1, mhat, l, o, t == 0, wsf, r32, hi);
            pack_p(p0, p1, pw);
        }
    }
    AT_WAIT_BAR(0);
    if (NT - 1 <= mylast) pv_tile<NDB>(o, (lcp)(lds + ((NT - 1) % NS) * SLOT + KSLOT), lane, hi, pw);
    if (grp == 0) AT_BAR();
    AT_BAR();
#undef SM_STAGE
#undef SM_WAITBAR
    l = xsum(l);
    if (hi == 0) wsf[32 + r32] = l;
    if (!DIFF) {
        float rs[16];
#pragma unroll
        for (int r = 0; r < 16; ++r) rs[r] = __builtin_amdgcn_rcpf(wsf[32 + crow(r, hi)]);
        const size_t orow0 = rowbase + qlo;
        store_o64(o, rs, (LAS float*)lds + wid * 2048, (const bf16_t*)(p.ws + WS_ZG0) + orow0 * 1024 + h * 64, ybase + orow0 * 1024 + h * 64, lane, r32, hi);
    } else {
        LAS float* X = (LAS float*)lds + rg * 4096;
        if (cc == 1) {
#pragma unroll
            for (int r = 0; r < 16; ++r) { const float rs = lam * __builtin_amdgcn_rcpf(wsf[32 + crow(r, hi)]); const int orow = crow(r, hi);
#pragma unroll
                for (int db = 0; db < 4; ++db) X[orow * 128 + db * 32 + r32] = o[db][r] * rs; }
        }
        AT_BAR();
        if (cc == 0) {
#pragma unroll
            for (int r = 0; r < 16; ++r) { const float rs = __builtin_amdgcn_rcpf(wsf[32 + crow(r, hi)]); const int orow = crow(r, hi);
#pragma unroll
                for (int db = 0; db < 4; ++db) { LAS float* xp = X + orow * 128 + db * 32 + r32; *xp = o[db][r] * rs - *xp; } }
            const int c4 = 4 * r32; const f32x4 g4 = *(const f32x4*)(p.subln_g + c4);
            const size_t yrow0 = rowbase + qlo;
#pragma unroll 4
            for (int i2 = 0; i2 < 16; ++i2) { const int row = 2 * i2 + hi; const f32x4 v = *(const LAS f32x4*)(X + row * 128 + c4);
                float ss = (v[0] * v[0] + v[1] * v[1]) + (v[2] * v[2] + v[3] * v[3]);
                ss += __shfl_xor(ss, 1); ss += __shfl_xor(ss, 2); ss += __shfl_xor(ss, 4); ss += __shfl_xor(ss, 8); ss += __shfl_xor(ss, 16);
                const float rstd = (1.0f - LAM_INIT) / sqrtf(ss * (1.0f / 128.0f) + SUBLN_EPS);
                const u32x2 z = *(const u32x2*)((const bf16_t*)(p.ws + WS_ZG1) + (yrow0 + row) * 1024 + h * 128 + c4);
                u32x2 w; w.x = cvtpk(v[0] * rstd * g4[0] * bf2f(z.x & 0xffffu), v[1] * rstd * g4[1] * bf2f(z.x >> 16)); w.y = cvtpk(v[2] * rstd * g4[2] * bf2f(z.y & 0xffffu), v[3] * rstd * g4[3] * bf2f(z.y >> 16));
                *(u32x2*)(ybase + (yrow0 + row) * 1024 + h * 128 + c4) = w; }
        }
    }
    AT_BAR();
}

constexpr int SB_PD = 3, SB_NS = 4, SB_SLOT = 16384;
__device__ __forceinline__ void sb_unit(const Ptrs& p, lp lds, int b, int h, int qb) {
    const int tid = threadIdx.x, lane = tid & 63, r32 = lane & 31, hi = lane >> 5, wid = __builtin_amdgcn_readfirstlane(tid >> 6);
    const size_t rowbase = (size_t)b * SEQ; const int q0 = qb * 256;
    const bf16_t* Qw = (const bf16_t*)(p.ws + WS_QSB) + (rowbase + q0 + wid * 32) * 512 + h * 64;
    const int NT = 4 * (qb + 1), td = 4 * qb + (wid >> 1), qrel = 32 * (wid & 1) + r32;
    LAS unsigned* flag = (LAS unsigned*)(lds + AT_FLAG);
    const unsigned lds0 = (unsigned)(size_t)lds;
    const bf16_t* Kt = (const bf16_t*)(p.ws + WS_KSB) + (size_t)((b * 8 + h) * 32) * 4096 + wid * 512 + lane * 8;
    const bf16_t* Vt = (const bf16_t*)(p.ws + WS_VSB) + (size_t)((b * 8 + h) * 32) * 4096 + wid * 512 + lane * 8;
#define SB_STAGE(it_) do { const unsigned so_ = (unsigned)(((it_) % SB_NS) * SB_SLOT); const size_t to_ = (size_t)(NT - 1 - (it_)) * 4096; \
        glds16(Kt + to_, (unsigned)__builtin_amdgcn_readfirstlane(lds0 + so_ + wid * 1024)); glds16(Vt + to_, (unsigned)__builtin_amdgcn_readfirstlane(lds0 + so_ + 8192 + wid * 1024)); } while (0)
    asm volatile("s_waitcnt vmcnt(0)" ::: "memory");
    for (int it = 0; it < SB_PD && it < NT; ++it) SB_STAGE(it);
    if (lane == 0) { flag[wid] = 0u; flag[8 + wid] = 0u; }
    bf16x8 qr[4];
#pragma unroll
    for (int d0 = 0; d0 < 4; ++d0) qr[d0] = *(const bf16x8*)(Qw + (size_t)r32 * 512 + d0 * 16 + hi * 8);
    f32x16 o[2]; o[0] = f32x16{}; o[1] = f32x16{}; float carry = 0.f; bool mydone = false;
    const f32x16 zero = {};
    for (int it = 0; it < NT; ++it) {
        const int t = NT - 1 - it;
        if (it + SB_PD <= NT) AT_WAIT_BAR(4); else AT_WAIT_BAR(0);
        { const LAS unsigned* fl = flag + ((it + 1) & 1) * 8; unsigned all = 1u;
#pragma unroll
          for (int w = 0; w < 8; ++w) all &= fl[w];
          if (it > 0 && all) break; }
        if (it + SB_PD < NT) SB_STAGE(it + SB_PD);
        if (t <= td && !mydone) {
            f32x16 z0, z1; u32x4 pw[4];
            qk_tile<4>(z0, z1, (lcp)(lds + (it % SB_NS) * SB_SLOT), qr, zero, r32, hi);
            f32x16 s0, s1; float G[8];
            const bool diag = (t == td);
#pragma unroll
            for (int r = 0; r < 16; ++r) {
                float a = fmaxf(z0[r], 0.f) + __builtin_amdgcn_logf(1.0f + __builtin_amdgcn_exp2f(-fabsf(z0[r])));
                float c = fmaxf(z1[r], 0.f) + __builtin_amdgcn_logf(1.0f + __builtin_amdgcn_exp2f(-fabsf(z1[r])));
                if (diag) { if (crow(r, hi) >= qrel) a = 0.f; if (32 + crow(r, hi) >= qrel) c = 0.f; }
                s0[r] = a; s1[r] = c; }
#pragma unroll
            for (int g = 0; g < 4; ++g) { G[g] = (s0[4 * g] + s0[4 * g + 1]) + (s0[4 * g + 2] + s0[4 * g + 3]); G[4 + g] = (s1[4 * g] + s1[4 * g + 1]) + (s1[4 * g + 2] + s1[4 * g + 3]); }
            float Gh[8], T[8];
#pragma unroll
            for (int m = 0; m < 8; ++m) { float lo_, hi_; xboth(G[m], lo_, hi_); Gh[m] = hi_; T[m] = lo_ + hi_; }
            float E[8]; float run = 0.f;
#pragma unroll
            for (int m = 7; m >= 0; --m) { E[m] = carry + run + (hi == 0 ? Gh[m] : 0.f); run += T[m]; }
            carry += run;
#pragma unroll
            for (int g = 0; g < 4; ++g) {
                float a3 = E[g] + s0[4 * g + 3], a2 = a3 + s0[4 * g + 2], a1 = a2 + s0[4 * g + 1], a0 = a1 + s0[4 * g];
                z0[4 * g] = __builtin_amdgcn_exp2f(z0[4 * g] - a0); z0[4 * g + 1] = __builtin_amdgcn_exp2f(z0[4 * g + 1] - a1); z0[4 * g + 2] = __builtin_amdgcn_exp2f(z0[4 * g + 2] - a2); z0[4 * g + 3] = __builtin_amdgcn_exp2f(z0[4 * g + 3] - a3);
                float b3 = E[4 + g] + s1[4 * g + 3], b2 = b3 + s1[4 * g + 2], b1 = b2 + s1[4 * g + 1], b0 = b1 + s1[4 * g];
                z1[4 * g] = __builtin_amdgcn_exp2f(z1[4 * g] - b0); z1[4 * g + 1] = __builtin_amdgcn_exp2f(z1[4 * g + 1] - b1); z1[4 * g + 2] = __builtin_amdgcn_exp2f(z1[4 * g + 2] - b2); z1[4 * g + 3] = __builtin_amdgcn_exp2f(z1[4 * g + 3] - b3); }
            if (diag) {
#pragma unroll
                for (int r = 0; r < 16; ++r) { if (crow(r, hi) >= qrel) z0[r] = 0.f; if (32 + crow(r, hi) >= qrel) z1[r] = 0.f; } }
            pack_p(z0, z1, pw);
            pv_tile<2>(o, (lcp)(lds + (it % SB_NS) * SB_SLOT + 8192), lane, hi, pw);
            mydone = __all(carry > SB_DONE);
        }
        if (lane == 0) flag[(it & 1) * 8 + wid] = mydone ? 1u : 0u;
    }
#undef SB_STAGE
    AT_WAIT_BAR(0);
    float rs[16];
#pragma unroll
    for (int r = 0; r < 16; ++r) rs[r] = 1.0f;
    const size_t orow0 = rowbase + q0 + wid * 32;
    store_o64(o, rs, (LAS float*)lds + wid * 2048, (const bf16_t*)(p.ws + WS_ZG0) + orow0 * 1024 + 512 + h * 64, (bf16_t*)(p.ws + WS_HY) + orow0 * 1024 + 512 + h * 64, lane, r32, hi);
    AT_BAR();
}
}

__device__ __forceinline__ void attn0_phase(Frame& F, const Ptrs& p) {
    for (int pi = F.vcu; pi < 256; pi += F.G) { const int x = pi >> 5, j = pi & 31, jj = j & 7;
        for (int r2 = 0; r2 < 2; ++r2) { const int bh = 8 * x + 4 * r2 + (j >> 3); at::sm_unit<false>(p, F.lds, bh >> 3, bh & 7, r2 ? 7 - jj : jj); }
        for (int r2 = 0; r2 < 2; ++r2) { const int bh = 8 * x + 4 * r2 + (j >> 3); at::sb_unit(p, F.lds, bh >> 3, bh & 7, r2 ? 7 - jj : jj); } }
}
__device__ __forceinline__ void attn1_phase(Frame& F, const Ptrs& p) {
    for (int pi = F.vcu; pi < 256; pi += F.G) { const int x = pi >> 5, j = pi & 31, jj = j & 15;
        for (int r4 = 0; r4 < 4; ++r4) { const int bh = 8 * x + 2 * r4 + (j >> 4); at::sm_unit<true>(p, F.lds, bh >> 3, bh & 7, (r4 & 1) ? 15 - jj : jj); } }
}
#ifdef PROBE_VAR
__device__ __forceinline__ void attn1_probe(Frame& F, const Ptrs& p) {
    for (int pi = F.vcu; pi < 256; pi += F.G) { const int bh = pi >> 2, s = pi & 3, b = bh >> 3, h = bh & 7;
        at::sm_unit<true, PROBE_VAR>(p, F.lds, b, h, 15 - s); at::sm_unit<true, PROBE_VAR>(p, F.lds, b, h, s); at::sm_unit<true, PROBE_VAR>(p, F.lds, b, h, 11 - s); at::sm_unit<true, PROBE_VAR>(p, F.lds, b, h, 4 + s); }
}
#endif
#ifndef FAST_MASK
#define FAST_MASK 0x7FF
#endif
constexpr int N_PHASES = 11;
struct Args { Ptrs p; int ph_lo, ph_hi, li, pad; };
__global__ void __launch_bounds__(NWAVES * 64, 2) mega(Args args) {
    extern __shared__ __attribute__((aligned(16))) unsigned char lds[];
    const Ptrs& p = args.p;
    Frame F;
    F.lds = (LAS unsigned char*)lds; F.MISC = (volatile LAS unsigned*)(F.lds + MISC_OFF);
    F.tid = threadIdx.x; F.lane = F.tid & 63; F.wave = __builtin_amdgcn_readfirstlane(F.tid >> 6);
    F.G = gridDim.x; { const int bx = blockIdx.x; F.vcu = (F.G % 8 == 0) ? (bx % 8) * (F.G / 8) + bx / 8 : bx; }
    F.ctl = (gu32*)(p.ws + WS_CTL);
    for (int u = F.tid; u < (LDS_BYTES - LDSCTL_OFF) / 4; u += NWAVES * 64) ((LAS unsigned*)(F.lds + LDSCTL_OFF))[u] = 0u;
    __syncthreads();
    XcdBarrier bar = xcd_barrier_post((unsigned*)(F.ctl + CW_BAR) + args.li * XCD_BAR_WORDS, F.MISC + 8);
    const int lo = args.ph_lo, hi = args.ph_hi;
#define IN(k) (lo <= (k) && (k) < hi)
#define SEAM(k) do { if (IN(k) && IN((k) + 1)) xcd_barrier(bar); } while (0)
    unsigned char* ws = p.ws;
    const float* MODG = (const float*)(ws + WS_MOD) + 2 * D;

#ifndef REPEAT_MASK
#define REPEAT_MASK 0
#endif
#define PHASE(k, ...) do { if (IN(k)) { __VA_ARGS__; if ((REPEAT_MASK >> (k)) & 1) { xcd_barrier(bar); __VA_ARGS__; } SEAM(k); } } while (0)
    PHASE(0, p0_prologue(F, p));
    PHASE(1, normmod_phase(F, p, p.x, 0));
    PHASE(2, { pg8::Gemm g{(const bf16_t*)(ws + WS_HY), (const bf16_t*)(ws + WS_W0T), M, N0P, D, D}; pg8::StaticOrder S; S.init(M, N0P, F.G, (int)blockIdx.x);
        pg8::EpiG1 E{ws}; pg8::gemm_phase<pg8::EpiG1, pg8::StaticOrder, true, true>(F.lds + RING_OFF, g, S, E); });
    PHASE(3, { { pg8::Gemm g{(const bf16_t*)(ws + WS_CKV), (const bf16_t*)(ws + WS_WUKVT), M, 1024, 256, 256}; pg8::StaticOrder S; S.init(M, 1024, F.G, (int)blockIdx.x);
          pg8::EpiUKV E{ws}; pg8::gemm_phase<pg8::EpiUKV, pg8::StaticOrder, true, true>(F.lds + RING_OFF, g, S, E); }
        { pg8::Gemm g{(const bf16_t*)(ws + WS_CQ), (const bf16_t*)(ws + WS_WUQT), M, 768, 384, 384}; pg8::StaticOrder S; S.init(M, 768, F.G, (int)blockIdx.x);
          pg8::EpiUQ E{ws}; pg8::gemm_phase<pg8::EpiUQ, pg8::StaticOrder, true, true>(F.lds + RING_OFF, g, S, E); } });
    PHASE(4, attn0_phase(F, p));
    PHASE(5, { pg8::Gemm g{(const bf16_t*)(ws + WS_HY), (const bf16_t*)(ws + WS_WO0T), M, D, D, D}; pg8::StaticOrder S; S.init(M, D, F.G, (int)blockIdx.x);
        pg8::EpiOut E{p.x, p.out, MODG}; pg8::gemm_phase<pg8::EpiOut, pg8::StaticOrder, true, true>(F.lds + RING_OFF, g, S, E); });
    PHASE(6, normmod_phase(F, p, p.out, 1));
    PHASE(7, { pg8::Gemm g{(const bf16_t*)(ws + WS_HY), (const bf16_t*)(ws + WS_W1T), M, DIFF_IN, D, D}; pg8::StaticOrder S; S.init(M, DIFF_IN, F.G, (int)blockIdx.x);
        pg8::EpiG4 E{ws}; pg8::gemm_phase<pg8::EpiG4, pg8::StaticOrder, true, true>(F.lds + RING_OFF, g, S, E); });
#ifdef PROBE_VAR
    PHASE(8, { attn1_phase(F, p); xcd_barrier(bar); attn1_probe(F, p); });
#else
    PHASE(8, attn1_phase(F, p));
#endif
    PHASE(9, { pg8::Gemm g{(const bf16_t*)(ws + WS_HY), (const bf16_t*)(ws + WS_WO1T), M, D, D, D}; pg8::StaticOrder S; S.init(M, D, F.G, (int)blockIdx.x);
        pg8::EpiOut E{p.out, p.out, MODG + (size_t)BATCH * MOD_W}; pg8::gemm_phase<pg8::EpiOut, pg8::StaticOrder, true, true>(F.lds + RING_OFF, g, S, E); });
    PHASE(10, final_phase(F, p));
#undef PHASE
#undef IN
#undef SEAM
}

extern "C" void kernel_launch(void* const* d_in, const int* in_sizes, int n_in, void* d_out, int out_size, void* d_ws, size_t ws_size, hipStream_t stream) {
    static int grid = 0;
    if (grid == 0) {
        if (n_in != 21 || out_size != M * D || ws_size < WS_END) { fprintf(stderr, "kernel_launch: unexpected shapes (n_in %d out %d ws %zu)\n", n_in, out_size, ws_size); grid = -1; return; }
        int dev = 0, cus = 0, per_cu = 0;
        if (hipGetDevice(&dev) != hipSuccess || hipDeviceGetAttribute(&cus, hipDeviceAttributeMultiprocessorCount, dev) != hipSuccess) { grid = -1; return; }
        if (hipFuncSetAttribute((const void*)mega, hipFuncAttributeMaxDynamicSharedMemorySize, LDS_BYTES) != hipSuccess) { fprintf(stderr, "kernel_launch: hipFuncSetAttribute failed\n"); grid = -1; return; }
        if (hipOccupancyMaxActiveBlocksPerMultiprocessor(&per_cu, (const void*)mega, NWAVES * 64, LDS_BYTES) != hipSuccess || per_cu < 1) { fprintf(stderr, "kernel_launch: occupancy query says %d blocks/CU\n", per_cu); (void)hipGetLastError(); grid = -1; return; }
        (void)hipGetLastError();
        grid = cus;
    }
    if (grid < 0) return;
    Ptrs p{};
    p.x = (const float*)d_in[0]; p.c = (const float*)d_in[1]; p.pos_offset = (const int*)d_in[2]; p.rel_table = (const float*)d_in[3]; p.ada_w = (const float*)d_in[4]; p.ada_b = (const float*)d_in[5];
    p.norm_g = (const float*)d_in[6]; p.final_g = (const float*)d_in[7]; p.ab_w_in = (const float*)d_in[8]; p.ab_q_norm_g = (const float*)d_in[9]; p.ab_kv_norm_g = (const float*)d_in[10];
    p.ab_w_uq = (const float*)d_in[11]; p.ab_w_ukv = (const float*)d_in[12]; p.ab_w_out = (const float*)d_in[13]; p.dif_w_in = (const float*)d_in[14];
    p.lq1 = (const float*)d_in[15]; p.lk1 = (const float*)d_in[16]; p.lq2 = (const float*)d_in[17]; p.lk2 = (const float*)d_in[18]; p.subln_g = (const float*)d_in[19]; p.dif_w_out = (const float*)d_in[20];
    p.out = (float*)d_out; p.ws = (unsigned char*)d_ws;
    (void)hipMemsetAsync((char*)d_ws + WS_CTL, 0, CTL_ZERO_BYTES, stream);
    int li = 0;
    for (int ph = 0; ph < N_PHASES;) {
        if ((FAST_MASK >> ph) & 1) {
            int e = ph; while (e < N_PHASES && ((FAST_MASK >> e) & 1)) ++e;
            Args a{}; a.p = p; a.ph_lo = ph; a.ph_hi = e; a.li = li++;
            hipLaunchKernelGGL(mega, dim3(grid), dim3(NWAVES * 64), LDS_BYTES, stream, a);
            ph = e;
        } else {
            nv::run_phase(ph, p, stream);
            if (ph == 2) nv::k_ssqp<<<M / 256, 256, 0, stream>>>(p);
            ++ph;
        }
    }
}
```
